# Optimizing an MI355X kernel written in HIP

```python
import math
import jax, jax.numpy as jnp
from jax import lax
import numpy as np

D_MODEL = 2048
BATCH = 4
SEQ = 2048
DEPTH = 2

GRID_W = 64
CTX_LEN = 256
BLOCK = 128
WINDOW = 128
ROPE_THETA = 10000.0
EPS = 1e-6
NEG_INF = -1e30

A_HEADS = 4
A_DK = 64
A_DV = 2 * A_DK
B_HEADS = 8
B_KV_HEADS = 2
B_GROUP = B_HEADS // B_KV_HEADS
B_DH = 128
C_HEADS = 4
C_Q_RANK = 512
C_KV_RANK = 256
C_NOPE = 128
C_ROPE = 64
C_DQK = C_NOPE + C_ROPE
C_DV = 128

SPLIT_SIZES = (A_HEADS * 2 * A_DK, A_HEADS * 2 * A_DK, A_HEADS * A_DV,
               B_HEADS * B_DH, B_KV_HEADS * B_DH, B_KV_HEADS * B_DH,
               C_Q_RANK, C_KV_RANK, C_ROPE)
D_IN = sum(SPLIT_SIZES)
D_MIX = A_HEADS * A_DV + B_HEADS * B_DH + C_HEADS * C_DV

N_EXPERTS = 32
N_GROUPS = 4
EXPERTS_PER_GROUP = N_EXPERTS // N_GROUPS
TOP_K = 2
GROUP_SCORE_K = 2
D_EXPERT = 512

kernel_name = 'hybrid_diffusion_block'


def rmsnorm(x, g):
    xf = x.astype(jnp.float32)
    y = xf * lax.rsqrt(jnp.mean(xf * xf, axis=-1, keepdims=True) + EPS)
    return (y * g.astype(jnp.float32)).astype(x.dtype)


def modulate(h, shift, scale):
    return h * (1 + scale) + shift


def ada_modulation(cond, w, bias):
    m = jax.nn.silu(cond) @ w + bias
    return jnp.split(m, 6, axis=-1)


def axial_rope(rows, dim):
    t = jnp.arange(rows * GRID_W)
    r = (t // GRID_W).astype(jnp.float32)
    col = (t % GRID_W).astype(jnp.float32)
    nf = dim // 4
    inv = ROPE_THETA ** (-jnp.arange(nf, dtype=jnp.float32) / nf)
    ang = jnp.concatenate([r[:, None] * inv, col[:, None] * inv], axis=-1)
    return jnp.cos(ang), jnp.sin(ang)


def apply_rope(x, cos, sin):
    shape = (cos.shape[0],) + (1,) * (x.ndim - 3) + (cos.shape[-1],)
    cos, sin = cos.reshape(shape), sin.reshape(shape)
    xf = x.astype(jnp.float32)
    x1, x2 = jnp.split(xf, 2, axis=-1)
    return jnp.concatenate([x1 * cos - x2 * sin, x1 * sin + x2 * cos], axis=-1).astype(x.dtype)


def split_cols(z):
    parts, off = [], 0
    for size in SPLIT_SIZES:
        parts.append(z[..., off:off + size])
        off += size
    return parts


def mixer_inputs(h, w_in, a_qn, a_kn, b_qn, b_kn, c_qa_norm, c_kva_norm, c_wuq, c_wukv,
                 c_qn, c_kn, rope):
    bsz, n = h.shape[:2]
    aq, ak, av, bq, bk, bv, cq, ckv, ckr = split_cols(h @ w_in)
    aq = rmsnorm(aq.reshape(bsz, n, A_HEADS, 2, A_DK), a_qn)
    ak = rmsnorm(ak.reshape(bsz, n, A_HEADS, 2, A_DK), a_kn)
    av = av.reshape(bsz, n, A_HEADS, A_DV)
    bq = rmsnorm(bq.reshape(bsz, n, B_HEADS, B_DH), b_qn)
    bk = rmsnorm(bk.reshape(bsz, n, B_KV_HEADS, B_DH), b_kn)
    bv = bv.reshape(bsz, n, B_KV_HEADS, B_DH)
    q = (rmsnorm(cq, c_qa_norm) @ c_wuq).reshape(bsz, n, C_HEADS, C_DQK)
    kv = (rmsnorm(ckv, c_kva_norm) @ c_wukv).reshape(bsz, n, C_HEADS, C_NOPE + C_DV)
    q_nope = rmsnorm(q[..., :C_NOPE], c_qn[:C_NOPE])
    q_rope = rmsnorm(q[..., C_NOPE:], c_qn[C_NOPE:])
    k_nope = rmsnorm(kv[..., :C_NOPE], c_kn[:C_NOPE])
    cv = kv[..., C_NOPE:]
    k_rope = rmsnorm(ckr, c_kn[C_NOPE:])
    if rope is not None:
        (cos_a, sin_a), (cos_b, sin_b), (cos_c, sin_c) = rope
        aq, ak = apply_rope(aq, cos_a, sin_a), apply_rope(ak, cos_a, sin_a)
        bq, bk = apply_rope(bq, cos_b, sin_b), apply_rope(bk, cos_b, sin_b)
        q_rope = apply_rope(q_rope, cos_c, sin_c)
        k_rope = apply_rope(k_rope, cos_c, sin_c)
    cq_full = jnp.concatenate([q_nope, q_rope], axis=-1)
    ck_full = jnp.concatenate(
        [k_nope, jnp.broadcast_to(k_rope[:, :, None, :], (bsz, n, C_HEADS, C_ROPE))], axis=-1)
    return aq, ak, av, bq, bk, bv, cq_full, ck_full, cv


def sweep_blocks(fn, q):
    bsz, n = q.shape[:2]
    nb = n // BLOCK
    qb = jnp.moveaxis(q.reshape((bsz, nb, BLOCK) + q.shape[2:]), 1, 0)
    ob = lax.map(fn, qb)
    return jnp.moveaxis(ob, 0, 1).reshape((bsz, n) + ob.shape[3:])


def diff_lambda(lv, layer_idx):
    lam_init = 0.8 - 0.6 * math.exp(-0.3 * layer_idx)
    lv = lv.astype(jnp.float32)
    lam = jnp.exp(jnp.sum(lv[0] * lv[1])) - jnp.exp(jnp.sum(lv[2] * lv[3])) + lam_init
    return lam, lam_init


def diff_attention(q, k, v, lam):
    s = jnp.einsum('bqhmd,bkhmd->bhmqk', q, k).astype(jnp.float32) * (A_DK ** -0.5)
    p = jax.nn.softmax(s, axis=-1)
    p = p[:, :, 0] - lam * p[:, :, 1]
    return jnp.einsum('bhqk,bkhd->bqhd', p.astype(v.dtype), v)


def mha(q, k, v, scale):
    s = jnp.einsum('bqhd,bkhd->bhqk', q, k).astype(jnp.float32) * scale
    p = jax.nn.softmax(s, axis=-1)
    return jnp.einsum('bhqk,bkhd->bqhd', p.astype(v.dtype), v)


def swa_latent(q, k, v, k_ctx, v_ctx, sink):
    bsz, n = q.shape[:2]
    nb = n // BLOCK
    qb = q.reshape(bsz, nb, BLOCK, B_KV_HEADS, B_GROUP, B_DH)

    def band(t):
        tp = jnp.pad(t, ((0, 0), (BLOCK, BLOCK), (0, 0), (0, 0)))
        tp = tp.reshape(bsz, nb + 2, BLOCK, B_KV_HEADS, B_DH)
        return jnp.concatenate([tp[:, :nb], tp[:, 1:nb + 1], tp[:, 2:]], axis=2)

    kb, vb = band(k), band(v)
    qpos = jnp.arange(nb)[:, None] * BLOCK + jnp.arange(BLOCK)[None, :]
    kpos = (jnp.arange(nb)[:, None] - 1) * BLOCK + jnp.arange(3 * BLOCK)[None, :]
    valid = ((jnp.abs(qpos[:, :, None] - kpos[:, None, :]) <= WINDOW)
             & (kpos[:, None, :] >= 0) & (kpos[:, None, :] < n))
    scale = B_DH ** -0.5
    s_loc = jnp.einsum('bnqhgd,bnkhd->bnhgqk', qb, kb).astype(jnp.float32) * scale
    s_loc = jnp.where(valid[None, :, None, None], s_loc, NEG_INF)
    s_ctx = jnp.einsum('bnqhgd,bchd->bnhgqc', qb, k_ctx).astype(jnp.float32) * scale
    s_sink = jnp.broadcast_to(
        sink.astype(jnp.float32).reshape(1, 1, B_KV_HEADS, B_GROUP, 1, 1), s_loc.shape[:-1] + (1,))
    p = jax.nn.softmax(jnp.concatenate([s_loc, s_ctx, s_sink], axis=-1), axis=-1)
    n_loc = 3 * BLOCK
    p_loc = p[..., :n_loc].astype(v.dtype)
    p_ctx = p[..., n_loc:n_loc + k_ctx.shape[1]].astype(v.dtype)
    out = (jnp.einsum('bnhgqk,bnkhd->bnqhgd', p_loc, vb)
           + jnp.einsum('bnhgqc,bchd->bnqhgd', p_ctx, v_ctx))
    return out.reshape(bsz, n, B_HEADS, B_DH)


def swa_context(q, k, v, sink):
    bsz, n = q.shape[:2]
    qg = q.reshape(bsz, n, B_KV_HEADS, B_GROUP, B_DH)
    s = jnp.einsum('bqhgd,bkhd->bhgqk', qg, k).astype(jnp.float32) * (B_DH ** -0.5)
    s_sink = jnp.broadcast_to(
        sink.astype(jnp.float32).reshape(1, B_KV_HEADS, B_GROUP, 1, 1), s.shape[:-1] + (1,))
    p = jax.nn.softmax(jnp.concatenate([s, s_sink], axis=-1), axis=-1)[..., :-1]
    out = jnp.einsum('bhgqk,bkhd->bqhgd', p.astype(v.dtype), v)
    return out.reshape(bsz, n, B_HEADS, B_DH)


def moe(h, router_w, router_bias, w_gate, w_up, w_down):
    t = h.shape[0]
    scores = jax.nn.sigmoid(h.astype(jnp.float32) @ router_w.astype(jnp.float32))
    sel = scores + router_bias.astype(jnp.float32)
    gscore = lax.top_k(sel.reshape(t, N_GROUPS, EXPERTS_PER_GROUP), GROUP_SCORE_K)[0].sum(-1)
    gidx = jnp.argmax(gscore, axis=-1)
    in_group = (jnp.arange(N_EXPERTS) // EXPERTS_PER_GROUP)[None, :] == gidx[:, None]
    _, eidx = lax.top_k(jnp.where(in_group, sel, NEG_INF), TOP_K)
    w = jnp.take_along_axis(scores, eidx, axis=-1)
    w = w / jnp.sum(w, axis=-1, keepdims=True)
    gates = jnp.sum(jax.nn.one_hot(eidx, N_EXPERTS, dtype=jnp.float32) * w[..., None], axis=1)
    gates = gates.astype(h.dtype)
    y = jnp.zeros_like(h)
    for e in range(N_EXPERTS):
        a = jax.nn.silu(h @ w_gate[e]) * (h @ w_up[e])
        y = y + gates[:, e:e + 1] * (a @ w_down[e])
    return y


def setup_inputs(seed: int = 0) -> dict:
    key = jax.random.key(seed)
    keys = iter(jax.random.split(key, 40))

    def nrm(shape, scale):
        return jax.random.normal(next(keys), shape, jnp.float32) * scale

    def gain(shape):
        return 1.0 + nrm(shape, 0.05)

    D = D_MODEL
    return {
        'x': nrm((BATCH, SEQ, D), 1.0),
        'c': nrm((BATCH, D), 1.0),
        'ctx': nrm((BATCH, CTX_LEN, D), 1.0),
        'c_ctx': nrm((D,), 1.0),
        'ada_w': nrm((DEPTH, D, 6 * D), 0.5 * D ** -0.5),
        'ada_b': nrm((DEPTH, 6 * D), 0.01),
        'norm1_g': gain((DEPTH, D)),
        'norm2_g': gain((DEPTH, D)),
        'w_in': nrm((DEPTH, D, D_IN), D ** -0.5),
        'w_out': nrm((DEPTH, D_MIX, D), D_MIX ** -0.5),
        'a_qn': gain((DEPTH, A_DK)),
        'a_kn': gain((DEPTH, A_DK)),
        'a_lambda': nrm((DEPTH, 4, A_DK), 0.1),
        'a_subln': gain((DEPTH, A_DV)),
        'b_qn': gain((DEPTH, B_DH)),
        'b_kn': gain((DEPTH, B_DH)),
        'b_sink': nrm((DEPTH, B_HEADS), 1.0),
        'c_qa_norm': gain((DEPTH, C_Q_RANK)),
        'c_kva_norm': gain((DEPTH, C_KV_RANK)),
        'c_wuq': nrm((DEPTH, C_Q_RANK, C_HEADS * C_DQK), C_Q_RANK ** -0.5),
        'c_wukv': nrm((DEPTH, C_KV_RANK, C_HEADS * (C_NOPE + C_DV)), C_KV_RANK ** -0.5),
        'c_qn': gain((DEPTH, C_DQK)),
        'c_kn': gain((DEPTH, C_DQK)),
        'router_w': nrm((D, N_EXPERTS), D ** -0.5),
        'router_bias': nrm((N_EXPERTS,), 0.01),
        'moe_w_gate': nrm((DEPTH, N_EXPERTS, D, D_EXPERT), D ** -0.5),
        'moe_w_up': nrm((DEPTH, N_EXPERTS, D, D_EXPERT), D ** -0.5),
        'moe_w_down': nrm((DEPTH, N_EXPERTS, D_EXPERT, D), D_EXPERT ** -0.5),
    }


def reference(x, c, ctx, c_ctx, ada_w, ada_b, norm1_g, norm2_g, w_in, w_out,
              a_qn, a_kn, a_lambda, a_subln, b_qn, b_kn, b_sink,
              c_qa_norm, c_kva_norm, c_wuq, c_wukv, c_qn, c_kn,
              router_w, router_bias, moe_w_gate, moe_w_up, moe_w_down):
    bsz, n_lat, d = x.shape
    n_ctx = ctx.shape[1]
    rows = n_lat // GRID_W
    rope = (axial_rope(rows, A_DK), axial_rope(rows, B_DH), axial_rope(rows, C_ROPE))
    xc = ctx
    for l in range(DEPTH):
        last = l == DEPTH - 1
        sh1, sc1, g1, sh2, sc2, g2 = [m[:, None, :] for m in ada_modulation(c, ada_w[l], ada_b[l])]
        sh1c, sc1c, g1c, sh2c, sc2c, g2c = ada_modulation(c_ctx, ada_w[l], ada_b[l])
        lp = (w_in[l], a_qn[l], a_kn[l], b_qn[l], b_kn[l], c_qa_norm[l], c_kva_norm[l],
              c_wuq[l], c_wukv[l], c_qn[l], c_kn[l])

        h = modulate(rmsnorm(x, norm1_g[l]), sh1, sc1)
        hc = modulate(rmsnorm(xc, norm1_g[l]), sh1c, sc1c)
        aq, ak, av, bq, bk, bv, cq, ck, cv = mixer_inputs(h, *lp, rope=rope)
        aqc, akc, avc, bqc, bkc, bvc, cqc, ckc, cvc = mixer_inputs(hc, *lp, rope=None)
        lam, lam_init = diff_lambda(a_lambda[l], l)

        ak_all, av_all = jnp.concatenate([ak, akc], axis=1), jnp.concatenate([av, avc], axis=1)
        ck_all, cv_all = jnp.concatenate([ck, ckc], axis=1), jnp.concatenate([cv, cvc], axis=1)
        o_a = sweep_blocks(lambda qb: diff_attention(qb, ak_all, av_all, lam), aq)
        o_a = rmsnorm(o_a, a_subln[l]) * (1.0 - lam_init)
        o_b = swa_latent(bq, bk, bv, bkc, bvc, b_sink[l])
        o_c = sweep_blocks(lambda qb: mha(qb, ck_all, cv_all, C_DQK ** -0.5), cq)
        mix = jnp.concatenate([o_a.reshape(bsz, n_lat, -1), o_b.reshape(bsz, n_lat, -1),
                               o_c.reshape(bsz, n_lat, -1)], axis=-1)
        x = x + g1 * (mix @ w_out[l])

        if not last:
            oc_a = rmsnorm(diff_attention(aqc, akc, avc, lam), a_subln[l]) * (1.0 - lam_init)
            oc_b = swa_context(bqc, bkc, bvc, b_sink[l])
            oc_c = mha(cqc, ckc, cvc, C_DQK ** -0.5)
            mixc = jnp.concatenate([oc_a.reshape(bsz, n_ctx, -1), oc_b.reshape(bsz, n_ctx, -1),
                                    oc_c.reshape(bsz, n_ctx, -1)], axis=-1)
            xc = xc + g1c * (mixc @ w_out[l])

        h2 = modulate(rmsnorm(x, norm2_g[l]), sh2, sc2).reshape(bsz * n_lat, d)
        if not last:
            h2c = modulate(rmsnorm(xc, norm2_g[l]), sh2c, sc2c).reshape(bsz * n_ctx, d)
            y = moe(jnp.concatenate([h2, h2c], axis=0), router_w, router_bias,
                    moe_w_gate[l], moe_w_up[l], moe_w_down[l])
            y_lat = y[:bsz * n_lat].reshape(bsz, n_lat, d)
            xc = xc + g2c * y[bsz * n_lat:].reshape(bsz, n_ctx, d)
        else:
            y_lat = moe(h2, router_w, router_bias, moe_w_gate[l], moe_w_up[l],
                        moe_w_down[l]).reshape(bsz, n_lat, d)
        x = x + g2 * y_lat
    return x
```

```cpp
#include <hip/hip_runtime.h>
#include <stdint.h>

typedef unsigned short bf16_t;

#define D_ 2048
#define NBATCH 4
#define SEQ 2048
#define CTXL 256
#define TPB 2304
#define NR 9216
#define DIN 3904
#define ZLD 4096
#define NEXP 32
#define DEXP 512
#define MAXSLOT 26624
#define EPS 1e-6f
#define LOG2E 1.4426950408889634f

__device__ __forceinline__ float bf2f(bf16_t v) { return __uint_as_float(((unsigned)v) << 16); }
__device__ __forceinline__ bf16_t f2bf(float f) { unsigned u = __float_as_uint(f); u += 0x7FFFu + ((u >> 16) & 1u); return (bf16_t)(u >> 16); }

struct P {
    const float *x, *c, *ctx, *c_ctx, *ada_w, *ada_b, *norm1_g, *norm2_g, *w_in, *w_out;
    const float *a_qn, *a_kn, *a_lambda, *a_subln, *b_qn, *b_kn, *b_sink;
    const float *c_qa_norm, *c_kva_norm, *c_wuq, *c_wukv, *c_qn, *c_kn;
    const float *router_w, *router_bias, *moe_w_gate, *moe_w_up, *moe_w_down;
    float *xw;
    float *xc;
    float *mod;
    float *cosA, *sinA;
    float *cosB, *sinB;
    bf16_t *hbuf;
    bf16_t *z;
    bf16_t *QA, *KA, *VtA;
    bf16_t *QB, *KB, *VtB;
    bf16_t *cqn, *ckvn, *krope;
    bf16_t *q2, *kv2;
    bf16_t *QC, *KC, *VtC;
    bf16_t *mix;
    int *cnt;
    int *slot_off;
    int *tok_e, *tok_pos;
    float *tok_w;
    bf16_t *Abuf;
    bf16_t *actbuf;
    bf16_t *yslot;
};

__device__ __forceinline__ float wave_sum(float v) {
#pragma unroll
    for (int o = 32; o >= 1; o >>= 1) v += __shfl_xor(v, o);
    return v;
}
__device__ __forceinline__ float wave_max(float v) {
#pragma unroll
    for (int o = 32; o >= 1; o >>= 1) v = fmaxf(v, __shfl_xor(v, o));
    return v;
}
__device__ __forceinline__ float block_sum256(float v, float* red) {
    v = wave_sum(v);
    __syncthreads();
    if ((threadIdx.x & 63) == 0) red[threadIdx.x >> 6] = v;
    __syncthreads();
    return red[0] + red[1] + red[2] + red[3];
}

__global__ __launch_bounds__(256) void k_mod(P p) {
    __shared__ float s[5][D_];
    const int l = blockIdx.y, n = blockIdx.x * 256 + threadIdx.x;
    for (int i = threadIdx.x; i < 5 * D_; i += 256) {
        const int r = i / D_, k = i % D_;
        const float v = r < 4 ? p.c[r * D_ + k] : p.c_ctx[k];
        s[r][k] = v / (1.0f + __expf(-v));
    }
    __syncthreads();
    float acc[5] = {0.f, 0.f, 0.f, 0.f, 0.f};
    const float* w = p.ada_w + (size_t)l * D_ * 6 * D_ + n;
    for (int k = 0; k < D_; ++k) {
        const float wv = w[(size_t)k * 6 * D_];
#pragma unroll
        for (int r = 0; r < 5; ++r) acc[r] += s[r][k] * wv;
    }
    const float bv = p.ada_b[l * 6 * D_ + n];
#pragma unroll
    for (int r = 0; r < 5; ++r) p.mod[((size_t)(l * 5 + r)) * 6 * D_ + n] = acc[r] + bv;
}

__global__ void k_rope(P p) {
    const int t = blockIdx.x;
    const int j = threadIdx.x;
    const float r = (float)(t / 64), col = (float)(t % 64);
    if (j < 32) {
        const int f = j & 15;
        const float inv = powf(10000.0f, -(float)f / 16.0f);
        const float ang = (j < 16 ? r : col) * inv;
        p.cosA[t * 32 + j] = cosf(ang); p.sinA[t * 32 + j] = sinf(ang);
    }
    {
        const int f = j & 31;
        const float inv = powf(10000.0f, -(float)f / 32.0f);
        const float ang = (j < 32 ? r : col) * inv;
        p.cosB[t * 64 + j] = cosf(ang); p.sinB[t * 64 + j] = sinf(ang);
    }
}

__global__ __launch_bounds__(256) void k_norm1(P p, int l) {
    __shared__ float red[4];
    const int R = blockIdx.x, b = R / TPB, t = R % TPB; const bool lat = t < SEQ;
    const float* src = lat ? p.xw + ((size_t)b * SEQ + t) * D_ : p.xc + ((size_t)b * CTXL + (t - SEQ)) * D_;
    const float* md = p.mod + ((size_t)(l * 5 + (lat ? b : 4))) * 6 * D_;
    const float* g = p.norm1_g + l * D_;
    float v[8]; float ss = 0.f;
#pragma unroll
    for (int i = 0; i < 8; ++i) { v[i] = src[threadIdx.x + 256 * i]; ss += v[i] * v[i]; }
    ss = block_sum256(ss, red);
    const float rstd = rsqrtf(ss / D_ + EPS);
#pragma unroll
    for (int i = 0; i < 8; ++i) { const int k = threadIdx.x + 256 * i; const float h = v[i] * rstd * g[k]; p.hbuf[(size_t)R * D_ + k] = f2bf(h * (1.0f + md[D_ + k]) + md[k]); }
}

template <int MODE> __global__ __launch_bounds__(256) void k_gemm(P p, int l) {
    __shared__ float As[16][68];
    __shared__ float Bs[16][68];
    __shared__ float Cs[16][68];
    const int tid = threadIdx.x, tx = tid & 15, ty = tid >> 4;
    const int row0 = blockIdx.x * 64, col0 = blockIdx.y * 64;
    const bf16_t* A; int lda, K, ldb; const float* B; const float* B2 = nullptr;
    if (MODE == 0) { A = p.hbuf; lda = D_; K = D_; B = p.w_in + (size_t)l * D_ * DIN; ldb = DIN; }
    if (MODE == 1) { A = p.cqn; lda = 512; K = 512; B = p.c_wuq + (size_t)l * 512 * 768; ldb = 768; }
    if (MODE == 2) { A = p.ckvn; lda = 256; K = 256; B = p.c_wukv + (size_t)l * 256 * 1024; ldb = 1024; }
    if (MODE == 3) { A = p.mix; lda = D_; K = D_; B = p.w_out + (size_t)l * D_ * D_; ldb = D_;
        if (l == 1 && (row0 % TPB) >= SEQ) return; }
    int e = 0;
    if (MODE == 4 || MODE == 5) {
        const int* off = p.slot_off + l * 33;
        if (row0 >= off[32]) return;
        for (int i = 0; i < 32; ++i) if (row0 >= off[i] && row0 < off[i + 1]) e = i;
    }
    if (MODE == 4) { A = p.Abuf; lda = D_; K = D_; B = p.moe_w_gate + ((size_t)(l * NEXP + e)) * D_ * DEXP; B2 = p.moe_w_up + ((size_t)(l * NEXP + e)) * D_ * DEXP; ldb = DEXP; }
    if (MODE == 5) { A = p.actbuf; lda = DEXP; K = DEXP; B = p.moe_w_down + ((size_t)(l * NEXP + e)) * DEXP * D_; ldb = D_; }
    float acc[4][4], acc2[4][4];
#pragma unroll
    for (int i = 0; i < 4; ++i)
#pragma unroll
        for (int j = 0; j < 4; ++j) { acc[i][j] = 0.f; acc2[i][j] = 0.f; }
    for (int k0 = 0; k0 < K; k0 += 16) {
        {
            const int r = tid >> 2, kk = (tid & 3) * 4;
            const bf16_t* ap = A + (size_t)(row0 + r) * lda + k0 + kk;
#pragma unroll
            for (int i = 0; i < 4; ++i) As[kk + i][r] = bf2f(ap[i]);
        }
        {
            const int kk = tid >> 4, cc = (tid & 15) * 4;
            const float* bp = B + (size_t)(k0 + kk) * ldb + col0 + cc;
#pragma unroll
            for (int i = 0; i < 4; ++i) Bs[kk][cc + i] = bp[i];
            if (MODE == 4) { const float* bp2 = B2 + (size_t)(k0 + kk) * ldb + col0 + cc;
#pragma unroll
                for (int i = 0; i < 4; ++i) Cs[kk][cc + i] = bp2[i]; }
        }
        __syncthreads();
#pragma unroll
        for (int kk = 0; kk < 16; ++kk) {
            float a[4], bb[4], b2[4];
#pragma unroll
            for (int i = 0; i < 4; ++i) { a[i] = As[kk][ty * 4 + i]; bb[i] = Bs[kk][tx * 4 + i]; b2[i] = (MODE == 4) ? Cs[kk][tx * 4 + i] : 0.f; }
#pragma unroll
            for (int i = 0; i < 4; ++i)
#pragma unroll
                for (int j = 0; j < 4; ++j) { acc[i][j] += a[i] * bb[j]; if (MODE == 4) acc2[i][j] += a[i] * b2[j]; }
        }
        __syncthreads();
    }
#pragma unroll
    for (int i = 0; i < 4; ++i) {
        const int R = row0 + ty * 4 + i;
#pragma unroll
        for (int j = 0; j < 4; ++j) {
            const int cidx = col0 + tx * 4 + j; const float v = acc[i][j];
            if (MODE == 0) p.z[(size_t)R * ZLD + cidx] = f2bf(v);
            if (MODE == 1) p.q2[(size_t)R * 768 + cidx] = f2bf(v);
            if (MODE == 2) p.kv2[(size_t)R * 1024 + cidx] = f2bf(v);
            if (MODE == 3) {
                const int b = R / TPB, t = R % TPB;
                if (t < SEQ) { const float g1 = p.mod[((size_t)(l * 5 + b)) * 6 * D_ + 2 * D_ + cidx]; p.xw[((size_t)b * SEQ + t) * D_ + cidx] += g1 * v; }
                else { const float g1 = p.mod[((size_t)(l * 5 + 4)) * 6 * D_ + 2 * D_ + cidx]; p.xc[((size_t)b * CTXL + (t - SEQ)) * D_ + cidx] += g1 * v; }
            }
            if (MODE == 4) { const float gg = v, uu = acc2[i][j]; p.actbuf[(size_t)R * DEXP + cidx] = f2bf(gg / (1.0f + __expf(-gg)) * uu); }
            if (MODE == 5) p.yslot[(size_t)R * D_ + cidx] = f2bf(v);
        }
    }
}

__global__ __launch_bounds__(256) void k_post1(P p, int l) {
    __shared__ float zs[DIN];
    __shared__ float rs[32];
    const int R = blockIdx.x, b = R / TPB, t = R % TPB; const bool lat = t < SEQ;
    const int tid = threadIdx.x, lane = tid & 63, w = tid >> 6;
    for (int i = tid; i < DIN; i += 256) zs[i] = bf2f(p.z[(size_t)R * ZLD + i]);
    __syncthreads();
    for (int s = w; s < 29; s += 4) {
        int off, len;
        if (s < 8) { off = s * 64; len = 64; }
        else if (s < 16) { off = 512 + (s - 8) * 64; len = 64; }
        else if (s < 24) { off = 1536 + (s - 16) * 128; len = 128; }
        else if (s < 26) { off = 2560 + (s - 24) * 128; len = 128; }
        else if (s == 26) { off = 3072; len = 512; }
        else if (s == 27) { off = 3584; len = 256; }
        else { off = 3840; len = 64; }
        float ss = 0.f;
        for (int i = lane; i < len; i += 64) { const float v = zs[off + i]; ss += v * v; }
        ss = wave_sum(ss);
        if (lane == 0) rs[s] = rsqrtf(ss / (float)len + EPS);
    }
    __syncthreads();
    const float scaleA = 0.125f * LOG2E;
    const float scaleB = 0.08838834764831845f * LOG2E;
    for (int idx = tid; idx < 1024; idx += 256) {
        const int which = idx >> 9, cc = idx & 511, seg = cc >> 6, d = cc & 63;
        const int base = which * 512 + seg * 64; const float r = rs[which * 8 + seg];
        const float* gain = (which ? p.a_kn : p.a_qn) + l * 64;
        float out;
        if (lat) {
            const int j = d & 31; const float cs = p.cosA[t * 32 + j], sn = p.sinA[t * 32 + j];
            const float v1 = zs[base + j] * r * gain[j], v2 = zs[base + j + 32] * r * gain[j + 32];
            out = d < 32 ? v1 * cs - v2 * sn : v1 * sn + v2 * cs;
        } else out = zs[base + d] * r * gain[d];
        if (which == 0) p.QA[(size_t)R * 512 + cc] = f2bf(out * scaleA); else p.KA[(size_t)R * 512 + cc] = f2bf(out);
    }
    for (int idx = tid; idx < 512; idx += 256) { const int h = idx >> 7, dv = idx & 127; p.VtA[((size_t)(b * 4 + h) * 128 + dv) * TPB + t] = f2bf(zs[1024 + idx]); }
    for (int idx = tid; idx < 1024; idx += 256) {
        const int h = idx >> 7, d = idx & 127; const int base = 1536 + h * 128; const float r = rs[16 + h]; const float* gain = p.b_qn + l * 128;
        float out;
        if (lat) {
            const int j = d & 63; const float cs = p.cosB[t * 64 + j], sn = p.sinB[t * 64 + j];
            const float v1 = zs[base + j] * r * gain[j], v2 = zs[base + j + 64] * r * gain[j + 64];
            out = d < 64 ? v1 * cs - v2 * sn : v1 * sn + v2 * cs;
        } else out = zs[base + d] * r * gain[d];
        p.QB[(size_t)R * 1024 + idx] = f2bf(out * scaleB);
    }
    {
        const int idx = tid; const int h = idx >> 7, d = idx & 127; const int base = 2560 + h * 128; const float r = rs[24 + h]; const float* gain = p.b_kn + l * 128;
        float out;
        if (lat) {
            const int j = d & 63; const float cs = p.cosB[t * 64 + j], sn = p.sinB[t * 64 + j];
            const float v1 = zs[base + j] * r * gain[j], v2 = zs[base + j + 64] * r * gain[j + 64];
            out = d < 64 ? v1 * cs - v2 * sn : v1 * sn + v2 * cs;
        } else out = zs[base + d] * r * gain[d];
        p.KB[(size_t)R * 256 + idx] = f2bf(out);
        p.VtB[((size_t)(b * 2 + h) * 128 + d) * TPB + t] = f2bf(zs[2816 + idx]);
    }
    for (int idx = tid; idx < 512; idx += 256) p.cqn[(size_t)R * 512 + idx] = f2bf(zs[3072 + idx] * rs[26] * p.c_qa_norm[l * 512 + idx]);
    p.ckvn[(size_t)R * 256 + tid] = f2bf(zs[3584 + tid] * rs[27] * p.c_kva_norm[l * 256 + tid]);
    if (tid < 64) {
        const int d = tid; const float r = rs[28]; const float* gain = p.c_kn + l * 192 + 128; float out;
        if (lat) {
            const int j = d & 31; const float cs = p.cosA[t * 32 + j], sn = p.sinA[t * 32 + j];
            const float v1 = zs[3840 + j] * r * gain[j], v2 = zs[3840 + j + 32] * r * gain[j + 32];
            out = d < 32 ? v1 * cs - v2 * sn : v1 * sn + v2 * cs;
        } else out = zs[3840 + d] * r * gain[d];
        p.krope[(size_t)R * 64 + d] = f2bf(out);
    }
}

__global__ __launch_bounds__(256) void k_post2(P p, int l) {
    __shared__ float qs[768];
    __shared__ float kvs[1024];
    __shared__ float rs[12];
    const int R = blockIdx.x, b = R / TPB, t = R % TPB; const bool lat = t < SEQ;
    const int tid = threadIdx.x, lane = tid & 63, w = tid >> 6;
    for (int i = tid; i < 768; i += 256) qs[i] = bf2f(p.q2[(size_t)R * 768 + i]);
    for (int i = tid; i < 1024; i += 256) kvs[i] = bf2f(p.kv2[(size_t)R * 1024 + i]);
    __syncthreads();
    for (int s = w; s < 12; s += 4) {
        float ss = 0.f; int len;
        if (s < 4) { len = 128; for (int i = lane; i < 128; i += 64) { const float v = qs[s * 192 + i]; ss += v * v; } }
        else if (s < 8) { len = 64; { const float v = qs[(s - 4) * 192 + 128 + lane]; ss += v * v; } }
        else { len = 128; for (int i = lane; i < 128; i += 64) { const float v = kvs[(s - 8) * 256 + i]; ss += v * v; } }
        ss = wave_sum(ss);
        if (lane == 0) rs[s] = rsqrtf(ss / (float)len + EPS);
    }
    __syncthreads();
    const float scaleC = 0.07216878364870323f * LOG2E;
    const float* qn = p.c_qn + l * 192; const float* kn = p.c_kn + l * 192;
    for (int idx = tid; idx < 768; idx += 256) {
        const int h = idx / 192, d = idx % 192; float out;
        if (d < 128) out = qs[idx] * rs[h] * qn[d];
        else {
            const int dd = d - 128; const float r = rs[4 + h]; const int base = h * 192 + 128;
            if (lat) {
                const int j = dd & 31; const float cs = p.cosA[t * 32 + j], sn = p.sinA[t * 32 + j];
                const float v1 = qs[base + j] * r * qn[128 + j], v2 = qs[base + j + 32] * r * qn[128 + j + 32];
                out = dd < 32 ? v1 * cs - v2 * sn : v1 * sn + v2 * cs;
            } else out = qs[base + dd] * r * qn[128 + dd];
        }
        p.QC[(size_t)R * 768 + idx] = f2bf(out * scaleC);
        bf16_t kout;
        if (d < 128) kout = f2bf(kvs[h * 256 + d] * rs[8 + h] * kn[d]); else kout = p.krope[(size_t)R * 64 + (d - 128)];
        p.KC[(size_t)R * 768 + idx] = kout;
    }
    for (int idx = tid; idx < 512; idx += 256) { const int h = idx >> 7, dv = idx & 127; p.VtC[((size_t)(b * 4 + h) * 128 + dv) * TPB + t] = f2bf(kvs[h * 256 + 128 + dv]); }
}

__device__ __forceinline__ void attend(const bf16_t* qp, int dqk, const bf16_t* Kb, int ldk, const bf16_t* Vt, int ka0, int ka1, int kb0, int kb1,
                                       bool has_sink, float sink_l2, float* qs, float* sc, int lane, float& o0, float& o1) {
    __syncthreads();
    for (int d = lane; d < dqk; d += 64) qs[d] = bf2f(qp[d]);
    __syncthreads();
    const int na = ka1 - ka0, nk = na + (kb1 - kb0);
    float m = -1e30f;
    for (int j = lane; j < nk; j += 64) {
        const int key = j < na ? ka0 + j : kb0 + (j - na);
        const bf16_t* kp = Kb + (size_t)key * ldk; float s = 0.f;
        for (int d = 0; d < dqk; d += 8) {
            const uint4 kv = *(const uint4*)(kp + d);
            const unsigned wv[4] = {kv.x, kv.y, kv.z, kv.w};
#pragma unroll
            for (int i = 0; i < 4; ++i) { s += qs[d + 2 * i] * __uint_as_float(wv[i] << 16); s += qs[d + 2 * i + 1] * __uint_as_float(wv[i] & 0xffff0000u); }
        }
        sc[j] = s; m = fmaxf(m, s);
    }
    m = wave_max(m);
    float ls = 0.f;
    for (int j = lane; j < nk; j += 64) { const float pv = exp2f(sc[j] - m); sc[j] = pv; ls += pv; }
    ls = wave_sum(ls);
    if (has_sink) ls += exp2f(sink_l2 - m);
    __syncthreads();
    const bf16_t* v0 = Vt + (size_t)lane * TPB; const bf16_t* v1 = Vt + (size_t)(lane + 64) * TPB;
    float a0 = 0.f, a1 = 0.f;
    for (int j = 0; j < nk; ++j) { const int key = j < na ? ka0 + j : kb0 + (j - na); const float pv = sc[j]; a0 += pv * bf2f(v0[key]); a1 += pv * bf2f(v1[key]); }
    const float inv = 1.0f / ls;
    o0 = a0 * inv; o1 = a1 * inv;
}

__global__ __launch_bounds__(256) void k_attn(P p, int l) {
    __shared__ float qs_all[4][192];
    __shared__ float sc_all[4][TPB];
    const int R = blockIdx.x, b = R / TPB, t = R % TPB; const bool lat = t < SEQ;
    if (!lat && l == 1) return;
    const int w = threadIdx.x >> 6, lane = threadIdx.x & 63;
    float* qs = qs_all[w]; float* sc = sc_all[w];
    const int slot = blockIdx.y * 4 + w;
    int ka0, ka1, kb0, kb1;
    if (!lat) { ka0 = SEQ; ka1 = TPB; kb0 = 0; kb1 = 0; }
    else if (blockIdx.y == 1 || blockIdx.y == 2) { ka0 = max(0, t - 128); ka1 = min(SEQ, t + 129); kb0 = SEQ; kb1 = TPB; }
    else { ka0 = 0; ka1 = TPB; kb0 = 0; kb1 = 0; }
    const size_t rb = (size_t)b * TPB;
    if (blockIdx.y == 0) {
        const int h = slot;
        const float* lv = p.a_lambda + l * 256;
        float s01 = 0.f, s23 = 0.f;
        s01 = wave_sum(lv[lane] * lv[64 + lane]); s23 = wave_sum(lv[128 + lane] * lv[192 + lane]);
        const float lam_init = 0.8f - 0.6f * expf(-0.3f * (float)l);
        const float lam = expf(s01) - expf(s23) + lam_init;
        float o0a, o1a, o0b, o1b;
        const bf16_t* Vt = p.VtA + (size_t)(b * 4 + h) * 128 * TPB;
        attend(p.QA + (size_t)R * 512 + h * 128, 64, p.KA + rb * 512 + h * 128, 512, Vt, ka0, ka1, kb0, kb1, false, 0.f, qs, sc, lane, o0a, o1a);
        attend(p.QA + (size_t)R * 512 + h * 128 + 64, 64, p.KA + rb * 512 + h * 128 + 64, 512, Vt, ka0, ka1, kb0, kb1, false, 0.f, qs, sc, lane, o0b, o1b);
        float o0 = o0a - lam * o0b, o1 = o1a - lam * o1b;
        const float ss = wave_sum(o0 * o0 + o1 * o1);
        const float r = rsqrtf(ss / 128.0f + EPS) * (1.0f - lam_init);
        const float* sg = p.a_subln + l * 128;
        p.mix[(size_t)R * D_ + h * 128 + lane] = f2bf(o0 * r * sg[lane]);
        p.mix[(size_t)R * D_ + h * 128 + lane + 64] = f2bf(o1 * r * sg[lane + 64]);
    } else if (blockIdx.y <= 2) {
        const int h = slot - 4, kvh = h >> 2;
        float o0, o1;
        attend(p.QB + (size_t)R * 1024 + h * 128, 128, p.KB + rb * 256 + kvh * 128, 256, p.VtB + (size_t)(b * 2 + kvh) * 128 * TPB, ka0, ka1, kb0, kb1,
               true, p.b_sink[l * 8 + h] * LOG2E, qs, sc, lane, o0, o1);
        p.mix[(size_t)R * D_ + 512 + h * 128 + lane] = f2bf(o0);
        p.mix[(size_t)R * D_ + 512 + h * 128 + lane + 64] = f2bf(o1);
    } else {
        const int h = slot - 12;
        float o0, o1;
        attend(p.QC + (size_t)R * 768 + h * 192, 192, p.KC + rb * 768 + h * 192, 768, p.VtC + (size_t)(b * 4 + h) * 128 * TPB, ka0, ka1, kb0, kb1,
               false, 0.f, qs, sc, lane, o0, o1);
        p.mix[(size_t)R * D_ + 1536 + h * 128 + lane] = f2bf(o0);
        p.mix[(size_t)R * D_ + 1536 + h * 128 + lane + 64] = f2bf(o1);
    }
}

__global__ __launch_bounds__(256) void k_norm2(P p, int l) {
    __shared__ float hs[D_];
    __shared__ float red[4];
    __shared__ float lg[32], scs[32], sel[32];
    const int R = blockIdx.x, b = R / TPB, t = R % TPB; const bool lat = t < SEQ;
    if (!lat && l == 1) return;
    const int tid = threadIdx.x, lane = tid & 63, w = tid >> 6;
    const float* src = lat ? p.xw + ((size_t)b * SEQ + t) * D_ : p.xc + ((size_t)b * CTXL + (t - SEQ)) * D_;
    const float* md = p.mod + ((size_t)(l * 5 + (lat ? b : 4))) * 6 * D_;
    const float* g = p.norm2_g + l * D_;
    float v[8]; float ss = 0.f;
#pragma unroll
    for (int i = 0; i < 8; ++i) { v[i] = src[tid + 256 * i]; ss += v[i] * v[i]; }
    ss = block_sum256(ss, red);
    const float rstd = rsqrtf(ss / D_ + EPS);
#pragma unroll
    for (int i = 0; i < 8; ++i) { const int k = tid + 256 * i; const float h = v[i] * rstd * g[k] * (1.0f + md[4 * D_ + k]) + md[3 * D_ + k]; hs[k] = h; p.hbuf[(size_t)R * D_ + k] = f2bf(h); }
    __syncthreads();
    float acc[8];
#pragma unroll
    for (int e = 0; e < 8; ++e) acc[e] = 0.f;
    for (int k = lane; k < D_; k += 64) {
        const float hv = hs[k]; const float* rw = p.router_w + (size_t)k * NEXP + w * 8;
#pragma unroll
        for (int e = 0; e < 8; ++e) acc[e] += hv * rw[e];
    }
#pragma unroll
    for (int e = 0; e < 8; ++e) { const float s = wave_sum(acc[e]); if (lane == 0) lg[w * 8 + e] = s; }
    __syncthreads();
    if (tid < 32) { const float s = 1.0f / (1.0f + expf(-lg[tid])); scs[tid] = s; sel[tid] = s + p.router_bias[tid]; }
    __syncthreads();
    if (tid == 0) {
        int gbest = 0; float gbv = -3e38f;
        for (int gi = 0; gi < 4; ++gi) {
            float t1 = -3e38f, t2 = -3e38f;
            for (int i = 0; i < 8; ++i) { const float s = sel[gi * 8 + i]; if (s > t1) { t2 = t1; t1 = s; } else if (s > t2) t2 = s; }
            const float gs = t1 + t2; if (gs > gbv) { gbv = gs; gbest = gi; }
        }
        int e0 = -1; float b0 = -3e38f;
        for (int i = 0; i < 8; ++i) { const float s = sel[gbest * 8 + i]; if (s > b0) { b0 = s; e0 = gbest * 8 + i; } }
        int e1 = -1; float b1 = -3e38f;
        for (int i = 0; i < 8; ++i) { const int e = gbest * 8 + i; if (e == e0) continue; const float s = sel[e]; if (s > b1) { b1 = s; e1 = e; } }
        const float w0 = scs[e0], w1 = scs[e1], inv = 1.0f / (w0 + w1);
        p.tok_e[R * 2] = e0; p.tok_e[R * 2 + 1] = e1;
        p.tok_w[R * 2] = w0 * inv; p.tok_w[R * 2 + 1] = w1 * inv;
        p.tok_pos[R * 2] = atomicAdd(&p.cnt[l * 32 + e0], 1);
        p.tok_pos[R * 2 + 1] = atomicAdd(&p.cnt[l * 32 + e1], 1);
    }
}

__global__ void k_slots(P p, int l) {
    if (threadIdx.x == 0) { int o = 0; for (int e = 0; e < 32; ++e) { p.slot_off[l * 33 + e] = o; o += (p.cnt[l * 32 + e] + 255) & ~255; } p.slot_off[l * 33 + 32] = o; }
}

__global__ __launch_bounds__(256) void k_permute(P p, int l) {
    const int R = blockIdx.x, t = R % TPB;
    if (t >= SEQ && l == 1) return;
    const uint4* src = (const uint4*)(p.hbuf + (size_t)R * D_);
#pragma unroll
    for (int j = 0; j < 2; ++j) {
        const int slot = p.slot_off[l * 33 + p.tok_e[R * 2 + j]] + p.tok_pos[R * 2 + j];
        uint4* dst = (uint4*)(p.Abuf + (size_t)slot * D_);
        dst[threadIdx.x] = src[threadIdx.x];
    }
}

__global__ __launch_bounds__(256) void k_combine(P p, int l) {
    const int R = blockIdx.x, b = R / TPB, t = R % TPB; const bool lat = t < SEQ;
    if (!lat && l == 1) return;
    float* dst = lat ? p.xw + ((size_t)b * SEQ + t) * D_ : p.xc + ((size_t)b * CTXL + (t - SEQ)) * D_;
    const float* g2 = p.mod + ((size_t)(l * 5 + (lat ? b : 4))) * 6 * D_ + 5 * D_;
    const int s0 = p.slot_off[l * 33 + p.tok_e[R * 2]] + p.tok_pos[R * 2], s1 = p.slot_off[l * 33 + p.tok_e[R * 2 + 1]] + p.tok_pos[R * 2 + 1];
    const float w0 = p.tok_w[R * 2], w1 = p.tok_w[R * 2 + 1];
    const bf16_t* y0 = p.yslot + (size_t)s0 * D_; const bf16_t* y1 = p.yslot + (size_t)s1 * D_;
    for (int k = threadIdx.x; k < D_; k += 256) dst[k] += g2[k] * (w0 * bf2f(y0[k]) + w1 * bf2f(y1[k]));
}

static inline size_t al256(size_t v) { return (v + 255) & ~(size_t)255; }

extern "C" void kernel_launch(void* const* d_in, const int* in_sizes, int n_in, void* d_out, int out_size, void* d_ws, size_t ws_size, hipStream_t stream) {
    (void)in_sizes; (void)n_in; (void)out_size; (void)ws_size;
    P p{};
    const float* const* in = (const float* const*)d_in;
    p.x = in[0]; p.c = in[1]; p.ctx = in[2]; p.c_ctx = in[3]; p.ada_w = in[4]; p.ada_b = in[5]; p.norm1_g = in[6]; p.norm2_g = in[7]; p.w_in = in[8]; p.w_out = in[9];
    p.a_qn = in[10]; p.a_kn = in[11]; p.a_lambda = in[12]; p.a_subln = in[13]; p.b_qn = in[14]; p.b_kn = in[15]; p.b_sink = in[16];
    p.c_qa_norm = in[17]; p.c_kva_norm = in[18]; p.c_wuq = in[19]; p.c_wukv = in[20]; p.c_qn = in[21]; p.c_kn = in[22];
    p.router_w = in[23]; p.router_bias = in[24]; p.moe_w_gate = in[25]; p.moe_w_up = in[26]; p.moe_w_down = in[27];
    char* ws = (char*)d_ws; size_t o = 0;
    auto take = [&](size_t bytes) { char* r = ws + o; o += al256(bytes); return r; };
    p.cnt = (int*)take(2 * 32 * 4);
    p.slot_off = (int*)take(2 * 33 * 4);
    p.xw = (float*)d_out;
    p.xc = (float*)take((size_t)NBATCH * CTXL * D_ * 4);
    p.mod = (float*)take((size_t)2 * 5 * 6 * D_ * 4);
    p.cosA = (float*)take(2048 * 32 * 4); p.sinA = (float*)take(2048 * 32 * 4);
    p.cosB = (float*)take(2048 * 64 * 4); p.sinB = (float*)take(2048 * 64 * 4);
    p.hbuf = (bf16_t*)take((size_t)NR * D_ * 2);
    p.z = (bf16_t*)take((size_t)NR * ZLD * 2);
    p.QA = (bf16_t*)take((size_t)NR * 512 * 2); p.KA = (bf16_t*)take((size_t)NR * 512 * 2); p.VtA = (bf16_t*)take((size_t)NR * 512 * 2);
    p.QB = (bf16_t*)take((size_t)NR * 1024 * 2); p.KB = (bf16_t*)take((size_t)NR * 256 * 2); p.VtB = (bf16_t*)take((size_t)NR * 256 * 2);
    p.cqn = (bf16_t*)take((size_t)NR * 512 * 2); p.ckvn = (bf16_t*)take((size_t)NR * 256 * 2); p.krope = (bf16_t*)take((size_t)NR * 64 * 2);
    p.q2 = (bf16_t*)take((size_t)NR * 768 * 2); p.kv2 = (bf16_t*)take((size_t)NR * 1024 * 2);
    p.QC = (bf16_t*)take((size_t)NR * 768 * 2); p.KC = (bf16_t*)take((size_t)NR * 768 * 2); p.VtC = (bf16_t*)take((size_t)NR * 512 * 2);
    p.mix = (bf16_t*)take((size_t)NR * D_ * 2);
    p.tok_e = (int*)take((size_t)NR * 2 * 4); p.tok_pos = (int*)take((size_t)NR * 2 * 4); p.tok_w = (float*)take((size_t)NR * 2 * 4);
    p.Abuf = (bf16_t*)take((size_t)MAXSLOT * D_ * 2);
    p.actbuf = (bf16_t*)take((size_t)MAXSLOT * DEXP * 2);
    p.yslot = p.Abuf;

    hipMemsetAsync(p.cnt, 0, 2 * 32 * 4, stream);
    hipMemcpyAsync(p.xw, p.x, (size_t)NBATCH * SEQ * D_ * 4, hipMemcpyDeviceToDevice, stream);
    hipMemcpyAsync(p.xc, p.ctx, (size_t)NBATCH * CTXL * D_ * 4, hipMemcpyDeviceToDevice, stream);
    k_mod<<<dim3(6 * D_ / 256, 2), 256, 0, stream>>>(p);
    k_rope<<<2048, 64, 0, stream>>>(p);
    for (int l = 0; l < 2; ++l) {
        k_norm1<<<NR, 256, 0, stream>>>(p, l);
        k_gemm<0><<<dim3(NR / 64, DIN / 64), 256, 0, stream>>>(p, l);
        k_post1<<<NR, 256, 0, stream>>>(p, l);
        k_gemm<1><<<dim3(NR / 64, 768 / 64), 256, 0, stream>>>(p, l);
        k_gemm<2><<<dim3(NR / 64, 1024 / 64), 256, 0, stream>>>(p, l);
        k_post2<<<NR, 256, 0, stream>>>(p, l);
        k_attn<<<dim3(NR, 4), 256, 0, stream>>>(p, l);
        k_gemm<3><<<dim3(NR / 64, D_ / 64), 256, 0, stream>>>(p, l);
        k_norm2<<<NR, 256, 0, stream>>>(p, l);
        k_slots<<<1, 64, 0, stream>>>(p, l);
        k_permute<<<NR, 256, 0, stream>>>(p, l);
        k_gemm<4><<<dim3(MAXSLOT / 64, DEXP / 64), 256, 0, stream>>>(p, l);
        k_gemm<5><<<dim3(MAXSLOT / 64, D_ / 64), 256, 0, stream>>>(p, l);
        k_combine<<<NR, 256, 0, stream>>>(p, l);
    }
}
```

```cpp
#include <hip/hip_runtime.h>
#include <stdint.h>
#include <cstdio>

typedef unsigned short bf16_t;

#define D_ 2048
#define NBATCH 4
#define SEQ 2048
#define CTXL 256
#define TPB 2304
#define NR 9216
#define DIN 3904
#define ZLD 4096
#define NEXP 32
#define DEXP 512
#define MAXSLOT 26624
#define EPS 1e-6f
#define LOG2E 1.4426950408889634f

__device__ __forceinline__ float bf2f(bf16_t v) { return __uint_as_float(((unsigned)v) << 16); }
__device__ __forceinline__ bf16_t f2bf(float f) { unsigned u = __float_as_uint(f); u += 0x7FFFu + ((u >> 16) & 1u); return (bf16_t)(u >> 16); }

constexpr size_t ws_al(size_t v) { return (v + 255) & ~(size_t)255; }
constexpr size_t WSO_bar = 0;
constexpr size_t CTL_BYTES = (size_t)3456 * 4 + 256 + 256 + 32 * 256 + 64 * 256;
#define CNT_STRIDE 64
constexpr size_t WSO_slot_off = WSO_bar + ws_al(CTL_BYTES);
constexpr size_t WSO_xc = WSO_slot_off + ws_al(2 * 33 * 4);
constexpr size_t WSO_mod = WSO_xc + ws_al((size_t)NBATCH * CTXL * D_ * 4);
constexpr size_t WSO_cosA = WSO_mod + ws_al((size_t)2 * 5 * 6 * D_ * 4);
constexpr size_t WSO_sinA = WSO_cosA + ws_al(2048 * 32 * 4);
constexpr size_t WSO_cosB = WSO_sinA + ws_al(2048 * 32 * 4);
constexpr size_t WSO_sinB = WSO_cosB + ws_al(2048 * 64 * 4);
constexpr size_t WSO_winT = WSO_sinB + ws_al(2048 * 64 * 4);
constexpr size_t WSO_woutT = WSO_winT + ws_al((size_t)2 * ZLD * D_ * 2);
constexpr size_t WSO_wuqT = WSO_woutT + ws_al((size_t)2 * D_ * D_ * 2);
constexpr size_t WSO_wukvT = WSO_wuqT + ws_al((size_t)2 * 768 * 512 * 2);
constexpr size_t WSO_guT = WSO_wukvT + ws_al((size_t)2 * 1024 * 256 * 2);
constexpr size_t WSO_dT = WSO_guT + ws_al((size_t)2 * NEXP * 1024 * D_ * 2);
constexpr size_t WSO_hbuf = WSO_dT + ws_al((size_t)2 * NEXP * D_ * DEXP * 2);
constexpr size_t WSO_z = WSO_hbuf + ws_al((size_t)NR * D_ * 2);
constexpr size_t WSO_QA = WSO_z + ws_al((size_t)NR * ZLD * 2);
constexpr size_t WSO_KA = WSO_QA + ws_al((size_t)NR * 512 * 2);
constexpr size_t WSO_QB = WSO_KA + ws_al((size_t)NR * 512 * 2);
constexpr size_t WSO_KB = WSO_QB + ws_al((size_t)NR * 1024 * 2);
constexpr size_t WSO_cqn = WSO_KB + ws_al((size_t)NR * 256 * 2);
constexpr size_t WSO_ckvn = WSO_cqn + ws_al((size_t)NR * 512 * 2);
constexpr size_t WSO_krope = WSO_ckvn + ws_al((size_t)NR * 256 * 2);
constexpr size_t WSO_q2 = WSO_krope + ws_al((size_t)NR * 64 * 2);
constexpr size_t WSO_kv2 = WSO_q2 + ws_al((size_t)NR * 768 * 2);
constexpr size_t WSO_QC = WSO_kv2 + ws_al((size_t)NR * 1024 * 2);
constexpr size_t WSO_KC = WSO_QC + ws_al((size_t)NR * 768 * 2);
constexpr size_t WSO_mix = WSO_KC + ws_al((size_t)NR * 768 * 2);
constexpr size_t WSO_oscr = WSO_mix + ws_al((size_t)NR * D_ * 2);
constexpr size_t WSO_tok_e = WSO_oscr + ws_al((size_t)256 * 256 * 128 * 4);
constexpr size_t WSO_tok_pos = WSO_tok_e + ws_al((size_t)NR * 2 * 4);
constexpr size_t WSO_tok_w = WSO_tok_pos + ws_al((size_t)NR * 2 * 4);
constexpr size_t WSO_Abuf = WSO_tok_w + ws_al((size_t)NR * 2 * 4);
constexpr size_t WSO_actbuf = WSO_Abuf + ws_al((size_t)MAXSLOT * D_ * 2);
constexpr size_t WS_END = WSO_actbuf + ws_al((size_t)MAXSLOT * DEXP * 2);
constexpr size_t WSO_tbl = WS_END;
constexpr size_t WSO_wgcnt = WS_END + 256;
constexpr size_t WSO_rwT = WSO_wgcnt + 2 * 256 * 32 * 4;
constexpr size_t WSO_dbuf = WSO_rwT + 2 * 32 * 2048 * 2;
constexpr size_t WS_END2 = WSO_dbuf + (size_t)NR * D_ * 2;
struct WsMap {
    float *xw;
    char *ws;
    __host__ __device__ __forceinline__ unsigned* bar() const { return (unsigned*)(ws + WSO_bar); }
    __host__ __device__ __forceinline__ int* slot_off() const { return (int*)(ws + WSO_slot_off); }
    __host__ __device__ __forceinline__ float* xc() const { return (float*)(ws + WSO_xc); }
    __host__ __device__ __forceinline__ float* mod() const { return (float*)(ws + WSO_mod); }
    __host__ __device__ __forceinline__ float* cosA() const { return (float*)(ws + WSO_cosA); }
    __host__ __device__ __forceinline__ float* sinA() const { return (float*)(ws + WSO_sinA); }
    __host__ __device__ __forceinline__ float* cosB() const { return (float*)(ws + WSO_cosB); }
    __host__ __device__ __forceinline__ float* sinB() const { return (float*)(ws + WSO_sinB); }
    __host__ __device__ __forceinline__ bf16_t* winT() const { return (bf16_t*)(ws + WSO_winT); }
    __host__ __device__ __forceinline__ bf16_t* woutT() const { return (bf16_t*)(ws + WSO_woutT); }
    __host__ __device__ __forceinline__ bf16_t* wuqT() const { return (bf16_t*)(ws + WSO_wuqT); }
    __host__ __device__ __forceinline__ bf16_t* wukvT() const { return (bf16_t*)(ws + WSO_wukvT); }
    __host__ __device__ __forceinline__ bf16_t* guT() const { return (bf16_t*)(ws + WSO_guT); }
    __host__ __device__ __forceinline__ bf16_t* dT() const { return (bf16_t*)(ws + WSO_dT); }
    __host__ __device__ __forceinline__ bf16_t* hbuf() const { return (bf16_t*)(ws + WSO_hbuf); }
    __host__ __device__ __forceinline__ bf16_t* z() const { return (bf16_t*)(ws + WSO_z); }
    __host__ __device__ __forceinline__ bf16_t* QA() const { return (bf16_t*)(ws + WSO_QA); }
    __host__ __device__ __forceinline__ bf16_t* KA() const { return (bf16_t*)(ws + WSO_KA); }
    __host__ __device__ __forceinline__ bf16_t* QB() const { return (bf16_t*)(ws + WSO_QB); }
    __host__ __device__ __forceinline__ bf16_t* KB() const { return (bf16_t*)(ws + WSO_KB); }
    __host__ __device__ __forceinline__ bf16_t* cqn() const { return (bf16_t*)(ws + WSO_cqn); }
    __host__ __device__ __forceinline__ bf16_t* ckvn() const { return (bf16_t*)(ws + WSO_ckvn); }
    __host__ __device__ __forceinline__ bf16_t* krope() const { return (bf16_t*)(ws + WSO_krope); }
    __host__ __device__ __forceinline__ bf16_t* q2() const { return (bf16_t*)(ws + WSO_q2); }
    __host__ __device__ __forceinline__ bf16_t* kv2() const { return (bf16_t*)(ws + WSO_kv2); }
    __host__ __device__ __forceinline__ bf16_t* QC() const { return (bf16_t*)(ws + WSO_QC); }
    __host__ __device__ __forceinline__ bf16_t* KC() const { return (bf16_t*)(ws + WSO_KC); }
    __host__ __device__ __forceinline__ bf16_t* mix() const { return (bf16_t*)(ws + WSO_mix); }
    __host__ __device__ __forceinline__ float* oscr() const { return (float*)(ws + WSO_oscr); }
    __host__ __device__ __forceinline__ int* tok_e() const { return (int*)(ws + WSO_tok_e); }
    __host__ __device__ __forceinline__ int* tok_pos() const { return (int*)(ws + WSO_tok_pos); }
    __host__ __device__ __forceinline__ float* tok_w() const { return (float*)(ws + WSO_tok_w); }
    __host__ __device__ __forceinline__ bf16_t* Abuf() const { return (bf16_t*)(ws + WSO_Abuf); }
    __host__ __device__ __forceinline__ bf16_t* actbuf() const { return (bf16_t*)(ws + WSO_actbuf); }
    __host__ __device__ __forceinline__ int* cnt() const { return (int*)(ws + WSO_bar + (size_t)3456 * 4 + 512 + 32 * 256); }
    __host__ __device__ __forceinline__ bf16_t* dbuf() const { return (bf16_t*)(ws + WSO_dbuf); }
    __host__ __device__ __forceinline__ bf16_t* rwT() const { return (bf16_t*)(ws + WSO_rwT); }
    __host__ __device__ __forceinline__ int* wgcnt() const { return (int*)(ws + WSO_wgcnt); }
    __host__ __device__ __forceinline__ int* qhead() const { return (int*)(ws + WSO_bar + (size_t)3456 * 4 + 256); }
    __host__ __device__ __forceinline__ int* pdone(int ph) const { return (int*)(ws + WSO_bar + (size_t)3456 * 4 + 512 + (size_t)ph * 256); }
    __host__ __device__ __forceinline__ bf16_t* yslot() const { return Abuf(); }
};
struct P : WsMap {
    static constexpr bool HAS_FIELDS = true;
    const float *x, *c, *ctx, *c_ctx, *ada_w, *ada_b, *norm1_g, *norm2_g, *w_in, *w_out;
    const float *a_qn, *a_kn, *a_lambda, *a_subln, *b_qn, *b_kn, *b_sink;
    const float *c_qa_norm, *c_kva_norm, *c_wuq, *c_wukv, *c_qn, *c_kn;
    const float *router_w, *router_bias, *moe_w_gate, *moe_w_up, *moe_w_down;
};
struct Q : WsMap {
    static constexpr bool HAS_FIELDS = false;
    __device__ __forceinline__ const float* tbl(int i) const { const unsigned long long v = ((const unsigned long long*)(ws + WSO_tbl))[i];
        return (const float*)(((unsigned long long)(unsigned)__builtin_amdgcn_readfirstlane((int)(v >> 32)) << 32) | (unsigned long long)(unsigned)__builtin_amdgcn_readfirstlane((int)(unsigned)v)); }
    __device__ __forceinline__ const float* x() const { return tbl(0); }
    __device__ __forceinline__ const float* c() const { return tbl(1); }
    __device__ __forceinline__ const float* ctx() const { return tbl(2); }
    __device__ __forceinline__ const float* c_ctx() const { return tbl(3); }
    __device__ __forceinline__ const float* ada_w() const { return tbl(4); }
    __device__ __forceinline__ const float* ada_b() const { return tbl(5); }
    __device__ __forceinline__ const float* norm1_g() const { return tbl(6); }
    __device__ __forceinline__ const float* norm2_g() const { return tbl(7); }
    __device__ __forceinline__ const float* w_in() const { return tbl(8); }
    __device__ __forceinline__ const float* w_out() const { return tbl(9); }
    __device__ __forceinline__ const float* a_qn() const { return tbl(10); }
    __device__ __forceinline__ const float* a_kn() const { return tbl(11); }
    __device__ __forceinline__ const float* a_lambda() const { return tbl(12); }
    __device__ __forceinline__ const float* a_subln() const { return tbl(13); }
    __device__ __forceinline__ const float* b_qn() const { return tbl(14); }
    __device__ __forceinline__ const float* b_kn() const { return tbl(15); }
    __device__ __forceinline__ const float* b_sink() const { return tbl(16); }
    __device__ __forceinline__ const float* c_qa_norm() const { return tbl(17); }
    __device__ __forceinline__ const float* c_kva_norm() const { return tbl(18); }
    __device__ __forceinline__ const float* c_wuq() const { return tbl(19); }
    __device__ __forceinline__ const float* c_wukv() const { return tbl(20); }
    __device__ __forceinline__ const float* c_qn() const { return tbl(21); }
    __device__ __forceinline__ const float* c_kn() const { return tbl(22); }
    __device__ __forceinline__ const float* router_w() const { return tbl(23); }
    __device__ __forceinline__ const float* router_bias() const { return tbl(24); }
    __device__ __forceinline__ const float* moe_w_gate() const { return tbl(25); }
    __device__ __forceinline__ const float* moe_w_up() const { return tbl(26); }
    __device__ __forceinline__ const float* moe_w_down() const { return tbl(27); }
};


__device__ __forceinline__ int lid() { int t = threadIdx.x; asm volatile("" : "+v"(t)); return t; }
__device__ __forceinline__ int sid(int v) { asm volatile("" : "+s"(v)); return v; }
__device__ __forceinline__ char* sidp(char* v) { asm volatile("" : "+s"(v)); return v; }
__device__ __forceinline__ float* sidp(float* v) { asm volatile("" : "+s"(v)); return v; }
__device__ __forceinline__ float shx(float v, int m) { return __int_as_float(__builtin_amdgcn_ds_bpermute(((lid() ^ m) & 63) << 2, __float_as_int(v))); }
__device__ __forceinline__ int bperm_i(int v, int src_lane) { return __builtin_amdgcn_ds_bpermute((src_lane & 63) << 2, v); }
__device__ __forceinline__ float wave_sum(float v) {
#pragma unroll
    for (int o = 32; o >= 1; o >>= 1) v += shx(v, o);
    return v;
}
template <int W> __device__ __forceinline__ float grp_sum(float v) {
#pragma unroll
    for (int o = W / 2; o >= 1; o >>= 1) v += shx(v, o);
    return v;
}
#define XB_TMO      128
#define XB_XCNT(j)  (256  + 64 * (j))
#define XB_XSUB(j)  (1280 + 64 * (j))
#define XB_XGEN(j)  (2304 + 64 * (j))
#define XB_TOP      3328
#define XB_TOPGEN   3392
#define XCD_BAR_WORDS 3456
#define XB_SPIN_CAP (1u << 18)
#define LAS __attribute__((address_space(3)))

__device__ __forceinline__ unsigned xb_ld(unsigned* p)              { return __hip_atomic_load(p, __ATOMIC_RELAXED, __HIP_MEMORY_SCOPE_AGENT); }
__device__ __forceinline__ unsigned xb_add(unsigned* p, unsigned v) { return __hip_atomic_fetch_add(p, v, __ATOMIC_RELAXED, __HIP_MEMORY_SCOPE_AGENT); }
__device__ __forceinline__ unsigned xb_xcc_id() { return (unsigned)__builtin_amdgcn_s_getreg((3 << 11) | 20) & 0xFu; }
#define XB_SPIN(cond, bar) do { unsigned _sp = 0; while (cond) { __builtin_amdgcn_s_sleep(1); \
    if ((++_sp & 255u) == 0u) { if (xb_ld(&(bar)[XB_TMO])) break; if (_sp > XB_SPIN_CAP) { atomicAdd(&(bar)[XB_TMO], 1u); break; } } } } while (0)

struct XcdBarrier {
    unsigned* bar; unsigned x;
    volatile LAS unsigned* st;
};

__device__ __forceinline__ XcdBarrier xcd_barrier_post(unsigned* bar, volatile LAS unsigned* st) {
    XcdBarrier b; b.bar = bar; b.x = xb_xcc_id(); b.st = st;
    if (threadIdx.x == 0) (void)xb_add(&bar[XB_XCNT(b.x)], 1u);
    return b;
}
__device__ __forceinline__ void xcd_barrier_complete(unsigned* bar, unsigned x, unsigned& nloc, unsigned& nx) {
    const unsigned G = gridDim.x * gridDim.y * gridDim.z;
    unsigned sum, cnt, mine, sp = 0u;
    for (;;) {
        sum = 0u; cnt = 0u; mine = 0u;
#pragma unroll
        for (unsigned j = 0; j < 16; ++j) { const unsigned c = xb_ld(&bar[XB_XCNT(j)]); sum += c; cnt += (c > 0u) ? 1u : 0u; mine = (j == x) ? c : mine; }
        if (sum == G) break;
        __builtin_amdgcn_s_sleep(1);
        if ((++sp & 255u) == 0u) { if (xb_ld(&bar[XB_TMO])) break; if (sp > XB_SPIN_CAP) { atomicAdd(&bar[XB_TMO], 1u); break; } }
    }
    nloc = mine > 0u ? mine : 1u; nx = cnt > 0u ? cnt : 1u;
}

__device__ __forceinline__ void xcd_barrier(const XcdBarrier& b) {
    asm volatile("s_waitcnt vmcnt(0)" ::: "memory");
    __syncthreads();
    if (threadIdx.x == 0) {
        unsigned* bar = b.bar;
        __builtin_amdgcn_s_waitcnt(0);
        unsigned nloc = b.st[0], nx = b.st[1];
        if (nloc == 0u) { xcd_barrier_complete(bar, b.x, nloc, nx); b.st[0] = nloc; b.st[1] = nx; }
        const unsigned old = xb_add(&bar[XB_XSUB(b.x)], 1u);
        const unsigned gen = old / nloc;
        if (old + 1u == (gen + 1u) * nloc) {
            __builtin_amdgcn_fence(__ATOMIC_RELEASE, "agent");
            asm volatile("s_waitcnt vmcnt(0)" ::: "memory");
            const unsigned og = xb_add(&bar[XB_TOP], 1u);
            const unsigned tg = og / nx;
            if (og + 1u == (tg + 1u) * nx) xb_add(&bar[XB_TOPGEN], 1u);
            else XB_SPIN(xb_ld(&bar[XB_TOPGEN]) == tg, bar);
            __builtin_amdgcn_fence(__ATOMIC_ACQUIRE, "agent");
            xb_add(&bar[XB_XGEN(b.x)], 1u);
            asm volatile("s_waitcnt vmcnt(0)" ::: "memory");
        } else {
            XB_SPIN(xb_ld(&bar[XB_XGEN(b.x)]) == gen, bar);
            __builtin_amdgcn_fence(__ATOMIC_ACQUIRE, "agent");
            asm volatile("s_waitcnt vmcnt(0)" ::: "memory");
        }
    }
    __syncthreads();
}
namespace pg8 {
#define PG8_LAS __attribute__((address_space(3)))
typedef unsigned short bf16_t;
typedef short bf16x8 __attribute__((ext_vector_type(8)));
typedef float f32x4 __attribute__((ext_vector_type(4)));
typedef unsigned u32x4 __attribute__((ext_vector_type(4)));
constexpr int BM = 256, BK = 64, HALF = 128, HTB = HALF * BK * 2  , STAGE_BYTES = 8 * HTB, NXCD = 8, WGM = 8;

__host__ __device__ __forceinline__ int lds_byte(int r, int c) { const int st = (r >> 4) * 2 + (c >> 5), rr = r & 15, cc = c & 31, ob = rr * 64 + cc * 2; return st * 1024 + (ob ^ (((ob >> 9) & 1) << 5)); }
__host__ __device__ __forceinline__ void stage_rc(int b, int& R, int& C) { const int st = b / 1024, sb = b % 1024, swz = sb ^ (((sb >> 9) & 1) << 5); R = (st >> 1) * 16 + swz / 64; C = (st & 1) * 32 + (swz % 64) / 2; }
__host__ __device__ __forceinline__ int perm32(int rho) { const int n = rho >> 4, i = rho & 15; return 8 * (i >> 2) + 4 * n + (i & 3); }

struct Unit { int pm, pn; };
struct Gemm { const bf16_t* A; const bf16_t* Bt; int M, N, K; };

struct StaticOrder {
    int nM, nN, nwg, G, c;
    __host__ __device__ void init(int M, int N, int G_, int c_) { nM = M / BM; nN = N / BM; nwg = nM * nN; G = G_; c = c_; }
    __host__ __device__ bool next(int i, Unit& u) const {
        const long L = (long)i * G + c; if (L >= nwg) return false;
        int wgid = (int)L; { const int q = nwg / NXCD, r = nwg % NXCD, xcd = wgid % NXCD, off = wgid / NXCD; wgid = (xcd < r ? xcd * (q + 1) : r * (q + 1) + (xcd - r) * q) + off; }
        const int nig = WGM * nN, gid = wgid / nig, fm = gid * WGM, gsz = (nM - fm) < WGM ? (nM - fm) : WGM;
        u.pm = fm + ((wgid % nig) % gsz); u.pn = (wgid % nig) / gsz; return true;
    }
    __device__ __forceinline__ void a_ready(const Unit&) const {}
    __device__ __forceinline__ void done(const Unit&) const {}
};
__device__ __forceinline__ unsigned cvt_pk_bf16(float lo, float hi) { unsigned r; asm volatile("v_cvt_pk_bf16_f32 %0, %1, %2" : "=v"(r) : "v"(lo), "v"(hi)); return r; }
template <class Epi, class Sched, bool STAMP = false>
__device__ __forceinline__ void gemm_phase(PG8_LAS unsigned char* lds, const Gemm g, const Sched& S, const Epi& E, unsigned long long* stamps) {
    const int tid = lid(), wid = __builtin_amdgcn_readfirstlane(tid >> 6), lane = tid & 63, wr = wid >> 2, wc = wid & 3, fr = lane & 15, fq = lane >> 4;
    const int K = g.K, nt = K / BK;
    int ts_lo = 0, ts_hi = 0, nts = 0; const unsigned long long rt_entry = STAMP ? (unsigned long long)wall_clock64() : 0ull;
#define PG8_STAMP() do { if (STAMP && wid == 0 && nts < 64) { const unsigned long long _c = (unsigned long long)clock64(); \
        ts_lo = (lane == nts) ? (int)(unsigned)_c : ts_lo; ts_hi = (lane == nts) ? (int)(unsigned)(_c >> 32) : ts_hi; ++nts; } } while (0)
    PG8_STAMP();
    unsigned voffA[2], voffB[2];
#pragma unroll
    for (int i = 0; i < 2; ++i) { int R, C; stage_rc(tid * 16 + i * 8192, R, C); const int Rb = Epi::PERM ? ((R & ~31) + perm32(R & 31)) : R;
        voffA[i] = (unsigned)(R * K + C) * 2u; voffB[i] = (unsigned)(Rb * K + C) * 2u; }
    const size_t kstep = (size_t)(BK * 2);
    const size_t hstep = (size_t)HALF * K * 2;
    const size_t tstep = 2 * hstep;
    const unsigned ldsw = (unsigned)wid * 1024u;
    const int aoff = lds_byte(wr * 64 + fr, fq * 8), boff = lds_byte(wc * 32 + fr, fq * 8);
#define PG8_SA(b, h) (((b) * 2 + (h)) * HTB)
#define PG8_SB(b, h) ((4 + (b) * 2 + (h)) * HTB)
#define PG8_STAGE(bufoff, gbase, voff) do { _Pragma("unroll") for (int _i = 0; _i < 2; ++_i) \
        __builtin_amdgcn_global_load_lds((const unsigned*)((const char*)(gbase) + (voff)[_i]), (PG8_LAS unsigned*)(lds + (bufoff) + ldsw + _i * 8192), 16, 0, 0); } while (0)
#define PG8_LDA(dst, b, h) do { _Pragma("unroll") for (int m = 0; m < 4; ++m) _Pragma("unroll") for (int k = 0; k < 2; ++k) dst[m][k] = *(const PG8_LAS bf16x8*)(lds + PG8_SA(b, h) + aoff + m * 2048 + k * 1024); } while (0)
#define PG8_LDB(dst, b, h) do { _Pragma("unroll") for (int n = 0; n < 2; ++n) _Pragma("unroll") for (int k = 0; k < 2; ++k) dst[n][k] = *(const PG8_LAS bf16x8*)(lds + PG8_SB(b, h) + boff + n * 2048 + k * 1024); } while (0)
#define PG8_MMA(ai, bj, At, Bt) do { __builtin_amdgcn_s_setprio(1); _Pragma("unroll") for (int m = 0; m < 4; ++m) _Pragma("unroll") for (int n = 0; n < 2; ++n) _Pragma("unroll") for (int k = 0; k < 2; ++k) \
        acc[ai][bj][m][n] = __builtin_amdgcn_mfma_f32_16x16x32_bf16(Bt[n][k], At[m][k], acc[ai][bj][m][n], 0, 0, 0); __builtin_amdgcn_s_setprio(0); } while (0)
#define PG8_WAIT_V(n) asm volatile("s_waitcnt vmcnt(" #n ")" ::: "memory")
#define PG8_WAIT_L(n) asm volatile("s_waitcnt lgkmcnt(" #n ")" ::: "memory")
#define PG8_BAR __builtin_amdgcn_s_barrier()
#define PG8_SCHED __builtin_amdgcn_sched_barrier(0)
    Unit cur, nxt; int ui = 0;
    if (!S.next(0, cur)) return;
    f32x4 acc[2][2][4][2];
#pragma unroll
    for (int a = 0; a < 2; ++a)
#pragma unroll
        for (int b = 0; b < 2; ++b)
#pragma unroll
            for (int m = 0; m < 4; ++m)
#pragma unroll
                for (int n = 0; n < 2; ++n) acc[a][b][m][n] = (f32x4){0.f, 0.f, 0.f, 0.f};
    bf16x8 At[4][2], B0[2][2], B1[2][2];
    const char* cA = (const char*)g.A + (size_t)cur.pm * tstep; const char* cB = (const char*)g.Bt + (size_t)cur.pn * tstep;
    S.a_ready(cur);
    PG8_STAGE(PG8_SB(0, 0), cB, voffB); PG8_STAGE(PG8_SA(0, 0), cA, voffA); PG8_STAGE(PG8_SB(0, 1), cB + hstep, voffB); PG8_STAGE(PG8_SA(0, 1), cA + hstep, voffA);
    if (wr == 1) PG8_BAR;
    PG8_WAIT_V(4); PG8_BAR;
    PG8_STAGE(PG8_SB(1, 0), cB + kstep, voffB); PG8_STAGE(PG8_SA(1, 0), cA + kstep, voffA); PG8_STAGE(PG8_SB(1, 1), cB + hstep + kstep, voffB);
    PG8_WAIT_V(6); PG8_BAR;
    PG8_STAMP();
    for (;;) {
        const bool has_next = S.next(ui + 1, nxt);
        const char* nA = has_next ? (const char*)g.A + (size_t)nxt.pm * tstep : cA; const char* nB = has_next ? (const char*)g.Bt + (size_t)nxt.pn * tstep : cB;
        for (int t = 0; t < nt; t += 2) {
            const bool last = (t == nt - 2);
            const char* a1 = cA + (size_t)(t + 1) * kstep;
            const char* a2 = last ? nA : cA + (size_t)(t + 2) * kstep; const char* b2 = last ? nB : cB + (size_t)(t + 2) * kstep;
            const char* a3 = a2 + kstep; const char* b3 = b2 + kstep;
            if (last && has_next) S.a_ready(nxt);
            PG8_LDB(B0, 0, 0); PG8_SCHED; PG8_LDA(At, 0, 0); PG8_STAGE(PG8_SA(1, 1), a1 + hstep, voffA);
            PG8_WAIT_L(8); PG8_BAR; PG8_WAIT_L(0); PG8_MMA(0, 0, At, B0); PG8_BAR; PG8_SCHED;
            PG8_LDB(B1, 0, 1); PG8_STAGE(PG8_SB(0, 0), b2, voffB);
            PG8_BAR; PG8_WAIT_L(0); PG8_MMA(0, 1, At, B1); PG8_BAR;
            PG8_LDA(At, 0, 1); PG8_STAGE(PG8_SA(0, 0), a2, voffA);
            PG8_BAR; PG8_WAIT_L(0); PG8_MMA(1, 0, At, B0); PG8_BAR; PG8_SCHED;
            PG8_STAGE(PG8_SB(0, 1), b2 + hstep, voffB);
            PG8_WAIT_V(6); PG8_BAR; PG8_MMA(1, 1, At, B1); PG8_BAR;
            PG8_LDB(B0, 1, 0); PG8_SCHED; PG8_LDA(At, 1, 0); PG8_STAGE(PG8_SA(0, 1), a2 + hstep, voffA);
            PG8_WAIT_L(8); PG8_BAR; PG8_WAIT_L(0); PG8_MMA(0, 0, At, B0); PG8_BAR; PG8_SCHED;
            PG8_LDB(B1, 1, 1); PG8_STAGE(PG8_SB(1, 0), b3, voffB);
            PG8_BAR; PG8_WAIT_L(0); PG8_MMA(0, 1, At, B1); PG8_BAR;
            PG8_LDA(At, 1, 1); PG8_STAGE(PG8_SA(1, 0), a3, voffA);
            PG8_BAR; PG8_WAIT_L(0); PG8_MMA(1, 0, At, B0); PG8_BAR; PG8_SCHED;
            PG8_STAGE(PG8_SB(1, 1), b3 + hstep, voffB);
            PG8_WAIT_V(6); PG8_BAR; PG8_MMA(1, 1, At, B1); PG8_BAR;
        }
        PG8_STAMP();
        if constexpr (!Epi::AFTER_DRAIN) { E(acc, cur, wr, wc, fr, fq); S.done(cur); }
        PG8_STAMP();
        if (!has_next) break;
#pragma unroll
        for (int a = 0; a < 2; ++a)
#pragma unroll
            for (int b = 0; b < 2; ++b)
#pragma unroll
                for (int m = 0; m < 4; ++m)
#pragma unroll
                    for (int n = 0; n < 2; ++n) acc[a][b][m][n] = (f32x4){0.f, 0.f, 0.f, 0.f};
        cur = nxt; cA = nA; cB = nB; ++ui;
    }
    PG8_WAIT_V(0);
    if (wr == 0) PG8_BAR;
    PG8_BAR;
    if constexpr (Epi::AFTER_DRAIN) { E.fused(acc, cur, wr, wc, fr, fq, lds, wid, lane); S.done(cur); }
    PG8_STAMP();
    if (STAMP && wid == 0) { stamps[lane] = lane < nts ? (((unsigned long long)(unsigned)ts_hi << 32) | (unsigned)ts_lo) : 0ull;
        if (lane == 62) stamps[62] = rt_entry; if (lane == 63) stamps[63] = (unsigned long long)wall_clock64(); }
#undef PG8_STAMP
#undef PG8_SA
#undef PG8_SB
#undef PG8_STAGE
#undef PG8_LDA
#undef PG8_LDB
#undef PG8_MMA
#undef PG8_WAIT_V
#undef PG8_WAIT_L
#undef PG8_BAR
#undef PG8_SCHED
}
}
struct EpiStore {
    static constexpr bool PERM = true, AFTER_DRAIN = false;
    bf16_t* O; int ldc; int pn_mask;
    __device__ __forceinline__ void operator()(const pg8::f32x4 (&acc)[2][2][4][2], const pg8::Unit& u, int wr, int wc, int fr, int fq) const {
        const int row0 = u.pm * 256 + wr * 64 + fr, col0 = (u.pn & pn_mask) * 256 + wc * 32 + 8 * fq;
#pragma unroll
        for (int ai = 0; ai < 2; ++ai)
#pragma unroll
            for (int m = 0; m < 4; ++m) { bf16_t* rowp = O + (size_t)(row0 + ai * 128 + m * 16) * ldc + col0;
#pragma unroll
                for (int bj = 0; bj < 2; ++bj) { const pg8::f32x4 v0 = acc[ai][bj][m][0], v1 = acc[ai][bj][m][1];
                    pg8::u32x4 w; w.x = pg8::cvt_pk_bf16(v0[0], v0[1]); w.y = pg8::cvt_pk_bf16(v0[2], v0[3]); w.z = pg8::cvt_pk_bf16(v1[0], v1[1]); w.w = pg8::cvt_pk_bf16(v1[2], v1[3]);
                    *(pg8::u32x4*)(rowp + bj * 128) = w; } }
    }
};
__device__ __forceinline__ float silu_f(float g) { return g * __builtin_amdgcn_rcpf(1.0f + __expf(-g)); }
struct EpiGateUp {
    static constexpr bool PERM = true, AFTER_DRAIN = false;
    bf16_t* O;
    __device__ __forceinline__ void operator()(const pg8::f32x4 (&acc)[2][2][4][2], const pg8::Unit& u, int wr, int wc, int fr, int fq) const {
        const int row0 = u.pm * 256 + wr * 64 + fr, col0 = (u.pn & 3) * 128 + wc * 32 + 8 * fq;
#pragma unroll
        for (int ai = 0; ai < 2; ++ai)
#pragma unroll
            for (int m = 0; m < 4; ++m) { bf16_t* rowp = O + (size_t)(row0 + ai * 128 + m * 16) * DEXP + col0;
                const pg8::f32x4 g0 = acc[ai][0][m][0], g1 = acc[ai][0][m][1], u0 = acc[ai][1][m][0], u1 = acc[ai][1][m][1];
                pg8::u32x4 w;
                w.x = pg8::cvt_pk_bf16(silu_f(g0[0]) * u0[0], silu_f(g0[1]) * u0[1]); w.y = pg8::cvt_pk_bf16(silu_f(g0[2]) * u0[2], silu_f(g0[3]) * u0[3]);
                w.z = pg8::cvt_pk_bf16(silu_f(g1[0]) * u1[0], silu_f(g1[1]) * u1[1]); w.w = pg8::cvt_pk_bf16(silu_f(g1[2]) * u1[2], silu_f(g1[3]) * u1[3]);
                *(pg8::u32x4*)rowp = w; }
    }
};
struct EpiOutProj {
    static constexpr bool PERM = true, AFTER_DRAIN = false;
    bf16_t* O; const float* modl;
    __device__ __forceinline__ void operator()(const pg8::f32x4 (&acc)[2][2][4][2], const pg8::Unit& u, int wr, int wc, int fr, int fq) const {
        const int b = u.pm / 9, tb = u.pm % 9; const bool lat = tb < 8;
        const float* g1 = modl + (size_t)(lat ? b : 4) * 6 * D_ + 2 * D_;
        const int row0 = u.pm * 256 + wr * 64 + fr, col0 = u.pn * 256 + wc * 32 + 8 * fq;
        pg8::f32x4 gv[2][2];
#pragma unroll
        for (int bj = 0; bj < 2; ++bj)
#pragma unroll
            for (int n = 0; n < 2; ++n) gv[bj][n] = *(const pg8::f32x4*)(g1 + col0 + bj * 128 + 4 * n);
#pragma unroll
        for (int ai = 0; ai < 2; ++ai)
#pragma unroll
            for (int m = 0; m < 4; ++m) { bf16_t* rowp = O + (size_t)(row0 + ai * 128 + m * 16) * D_ + col0;
#pragma unroll
                for (int bj = 0; bj < 2; ++bj) { const pg8::f32x4 v0 = acc[ai][bj][m][0] * gv[bj][0], v1 = acc[ai][bj][m][1] * gv[bj][1];
                    pg8::u32x4 w; w.x = pg8::cvt_pk_bf16(v0[0], v0[1]); w.y = pg8::cvt_pk_bf16(v0[2], v0[3]); w.z = pg8::cvt_pk_bf16(v1[0], v1[1]); w.w = pg8::cvt_pk_bf16(v1[2], v1[3]);
                    *(pg8::u32x4*)(rowp + bj * 128) = w; } }
    }
};
struct MapOrder : pg8::StaticOrder {
    int skipctx;
    __device__ bool next(int i, pg8::Unit& u) const { if (!pg8::StaticOrder::next(i, u)) return false; if (skipctx) u.pm = (u.pm >> 3) * 9 + (u.pm & 7); return true; }
};
struct MoeOrder {
    const PG8_LAS int* tab; int nN, G, c;
    __device__ bool next(int i, pg8::Unit& u) const {
        const long L = (long)i * G + c; const int ntile = tab[0];
        if (L >= (long)ntile * nN) return false;
        const int tile = (int)(L / nN), j = (int)(L % nN);
        u.pm = tile; u.pn = tab[8 + tile] * nN + j; return true;
    }
    __device__ __forceinline__ void a_ready(const pg8::Unit&) const {}
    __device__ __forceinline__ void done(const pg8::Unit&) const {}
};
namespace att {
#define ATT_LAS __attribute__((address_space(3)))
using bf16x8 = __attribute__((ext_vector_type(8))) short;
using s16x4  = __attribute__((ext_vector_type(4))) short;
using f32x16 = __attribute__((ext_vector_type(16))) float;
using u32x4  = __attribute__((ext_vector_type(4))) unsigned;
using u32x2  = __attribute__((ext_vector_type(2))) unsigned;
constexpr int QBLK = 32, KVBLK = 64, SHM_V = KVBLK * 128 * 2;
constexpr float THR2 = 11.0f;
#define ATT_SBAR() __builtin_amdgcn_sched_barrier(0)
__device__ __forceinline__ int crow(int r, int hi) { return (r & 3) + 8 * (r >> 2) + 4 * hi; }
__device__ __forceinline__ unsigned cvtpk(float lo, float hi) { unsigned r; asm volatile("v_cvt_pk_bf16_f32 %0, %1, %2" : "=v"(r) : "v"(lo), "v"(hi)); return r; }

__device__ __forceinline__ void mask_tile(f32x16& p0, f32x16& p1, int dq) {
    const float NEG = -__builtin_inff();
#pragma unroll
    for (int r = 0; r < 16; ++r) {
        const int c = (r & 3) + 8 * (r >> 2);
        if ((unsigned)(dq - c) >= 257u) p0[r] = NEG;
        if ((unsigned)(dq - c - 32) >= 257u) p1[r] = NEG;
    }
}
__device__ __forceinline__ void partialSM(f32x16& p0, f32x16& p1, float& m_reg, float& mn, float& alpha) {
    float pmax = p0[0];
#pragma unroll
    for (int r = 1; r < 16; ++r) pmax = fmaxf(pmax, p0[r]);
#pragma unroll
    for (int r = 0; r < 16; ++r) pmax = fmaxf(pmax, p1[r]);
    { auto rr = __builtin_amdgcn_permlane32_swap(__float_as_uint(pmax), __float_as_uint(pmax), false, false);
      pmax = fmaxf(__uint_as_float(rr[0]), __uint_as_float(rr[1])); }
    if (__builtin_expect(__all(pmax - m_reg <= THR2), 1)) { mn = m_reg; alpha = 1.f; }
    else { mn = fmaxf(m_reg, pmax); alpha = __builtin_amdgcn_exp2f(m_reg - mn); m_reg = mn; }
#pragma unroll
    for (int r = 0; r < 16; ++r) p0[r] = p0[r] - mn;
#pragma unroll
    for (int r = 0; r < 16; ++r) p1[r] = p1[r] - mn;
#pragma unroll
    for (int r = 0; r < 16; ++r) p0[r] = __builtin_amdgcn_exp2f(p0[r]);
}
__device__ __forceinline__ void finishSM(f32x16& p0, f32x16& p1, float alpha, float& l_reg, bf16x8& pa0, bf16x8& pa1, bf16x8& pa2, bf16x8& pa3) {
#pragma unroll
    for (int r = 0; r < 16; ++r) p1[r] = __builtin_amdgcn_exp2f(p1[r]);
    float ps = 0;
#pragma unroll
    for (int r = 0; r < 16; ++r) ps += p0[r];
#pragma unroll
    for (int r = 0; r < 16; ++r) ps += p1[r];
    { auto rr = __builtin_amdgcn_permlane32_swap(__float_as_uint(ps), __float_as_uint(ps), false, false);
      ps = __uint_as_float(rr[0]) + __uint_as_float(rr[1]); }
    l_reg = l_reg * alpha + ps;
#define ATT_PK4(P, BASE, OUT) do { unsigned a0 = cvtpk(P[BASE + 0], P[BASE + 1]), a1 = cvtpk(P[BASE + 2], P[BASE + 3]);   \
    unsigned b0 = cvtpk(P[BASE + 4], P[BASE + 5]), b1 = cvtpk(P[BASE + 6], P[BASE + 7]);                              \
    auto r0 = __builtin_amdgcn_permlane32_swap(a0, b0, false, false); auto r1 = __builtin_amdgcn_permlane32_swap(a1, b1, false, false); \
    u32x4 w = {r0[0], r1[0], r0[1], r1[1]}; OUT = *reinterpret_cast<bf16x8*>(&w); } while (0)
    ATT_PK4(p0, 0, pa0); ATT_PK4(p0, 8, pa1); ATT_PK4(p1, 0, pa2); ATT_PK4(p1, 8, pa3);
#undef ATT_PK4
}
template <int DQK, int QL> __device__ __forceinline__ void qkt(f32x16& p0, f32x16& p1, const ATT_LAS unsigned char* Ks, const bf16x8 (&qr)[DQK / 16 - QL], const ATT_LAS unsigned char* Qs, int r32, int hi) {
    constexpr int KROW = 2 * DQK + 16;
    p0 = f32x16{}; p1 = f32x16{};
    if (QL > 0) asm volatile("" : "+v"(Qs));
#pragma unroll
    for (int d0 = 0; d0 < DQK / 16; ++d0) { const int cb = (d0 * 16 + hi * 8) * 2;
        const bf16x8 b0 = *reinterpret_cast<const ATT_LAS bf16x8*>(Ks + r32 * KROW + cb);
        const bf16x8 b1 = *reinterpret_cast<const ATT_LAS bf16x8*>(Ks + (32 + r32) * KROW + cb);
        bf16x8 q;
        if (d0 < DQK / 16 - QL) q = qr[d0 < DQK / 16 - QL ? d0 : 0];
        else q = *reinterpret_cast<const ATT_LAS bf16x8*>(Qs + (d0 - (DQK / 16 - QL)) * 32);
        p0 = __builtin_amdgcn_mfma_f32_32x32x16_bf16(b0, q, p0, 0, 0, 0);
        p1 = __builtin_amdgcn_mfma_f32_32x32x16_bf16(b1, q, p1, 0, 0, 0);
        if (DQK > 128 && (d0 & 3) == 3) ATT_SBAR(); }
}
__device__ __forceinline__ int v_st(int k, int c) { const int kk = (k & ~0xC) | ((k & 4) << 1) | ((k & 8) >> 1); return ((kk >> 3) * 4 + (c >> 5)) * 512 + ((kk & 7) * 32 + (c & 31)) * 2; }
__device__ __forceinline__ int v_rd_base(int lane) { return ((lane & 3) << 3) | (((lane >> 2) & 3) << 6) | (((lane >> 4) & 1) << 5) | (((lane >> 5) & 1) << 8); }
constexpr int v_rd_off(int d0, int ks, int half) { return d0 * 512 + ks * 4096 + half * 2048; }
template <int OFF> __device__ __forceinline__ s16x4 tr_read(int vb) {
    s16x4 r; asm volatile("ds_read_b64_tr_b16 %0, %1 offset:%2" : "=&v"(r) : "v"(vb), "i"(OFF) : "memory"); return r;
}
template <int D0> __device__ __forceinline__ void pv_one(f32x16& od, int vb, bf16x8 pa0, bf16x8 pa1, bf16x8 pa2, bf16x8 pa3) {
    const s16x4 l0 = tr_read<v_rd_off(D0, 0, 0)>(vb), h0 = tr_read<v_rd_off(D0, 0, 1)>(vb), l1 = tr_read<v_rd_off(D0, 1, 0)>(vb), h1 = tr_read<v_rd_off(D0, 1, 1)>(vb);
    const s16x4 l2 = tr_read<v_rd_off(D0, 2, 0)>(vb), h2 = tr_read<v_rd_off(D0, 2, 1)>(vb), l3 = tr_read<v_rd_off(D0, 3, 0)>(vb), h3 = tr_read<v_rd_off(D0, 3, 1)>(vb);
    asm volatile("s_waitcnt lgkmcnt(0)" ::: "memory"); ATT_SBAR();
#define ATT_PK(L, H) (bf16x8){L[0], L[1], L[2], L[3], H[0], H[1], H[2], H[3]}
    od = __builtin_amdgcn_mfma_f32_32x32x16_bf16(pa0, ATT_PK(l0, h0), od, 0, 0, 0);
    od = __builtin_amdgcn_mfma_f32_32x32x16_bf16(pa1, ATT_PK(l1, h1), od, 0, 0, 0);
    od = __builtin_amdgcn_mfma_f32_32x32x16_bf16(pa2, ATT_PK(l2, h2), od, 0, 0, 0);
    od = __builtin_amdgcn_mfma_f32_32x32x16_bf16(pa3, ATT_PK(l3, h3), od, 0, 0, 0);
#undef ATT_PK
}
__device__ __forceinline__ void pv_d0(f32x16 (&o)[4], int vb, bf16x8 pa0, bf16x8 pa1, bf16x8 pa2, bf16x8 pa3) {
    pv_one<0>(o[0], vb, pa0, pa1, pa2, pa3); pv_one<1>(o[1], vb, pa0, pa1, pa2, pa3); pv_one<2>(o[2], vb, pa0, pa1, pa2, pa3); pv_one<3>(o[3], vb, pa0, pa1, pa2, pa3);
}
template <int DQK> constexpr int lds_bytes() { return 2 * SHM_V + 2 * 64 * (2 * DQK + 16) + 8 * 64 * 4 + 256 * 176; }

template <int DQK, bool MASK, int SD, int QL>
__device__ __forceinline__ void attn_body(ATT_LAS unsigned char* lds, const bf16_t* __restrict__ Qb, int ldq, const bf16_t* __restrict__ Kh, int ldk,
                                          const bf16_t* __restrict__ Vh, int ldv, int nt, int n0, int s0, int s1, int qpos0, int rot,
                                          f32x16 (&o)[4], float& m_reg, float& l_reg) {
    constexpr int KROW = 2 * DQK + 16, SHM_K = 64 * KROW, NCH = DQK / 8, KPT = DQK / 64;
    const int tid = lid(), wid = __builtin_amdgcn_readfirstlane(tid >> 6), lane = tid & 63, r32 = lane & 31, hi = lane >> 5;
    ATT_LAS unsigned char* V_lds = lds; ATT_LAS unsigned char* K_lds = lds + 2 * SHM_V;
    ATT_LAS float* al_l = (ATT_LAS float*)(lds + 2 * SHM_V + 2 * SHM_K) + wid * 64 + 32;
    m_reg = -1e30f; l_reg = 0.f;
#pragma unroll
    for (int d = 0; d < 4; ++d) o[d] = f32x16{};
    bf16x8 qr[DQK / 16 - QL];
    const bf16_t* Qw = Qb + (size_t)(wid * QBLK + r32) * ldq + hi * 8;
#pragma unroll
    for (int d0 = 0; d0 < DQK / 16 - QL; ++d0) qr[d0] = *reinterpret_cast<const bf16x8*>(Qw + d0 * 16);
    ATT_LAS unsigned char* Qs = lds + 2 * SHM_V + 2 * SHM_K + 8 * 64 * 4 + (wid * QBLK + r32) * (QL * 32 + 16) + hi * 16;
#pragma unroll
    for (int d0 = 0; d0 < QL; ++d0) *reinterpret_cast<ATT_LAS bf16x8*>(Qs + d0 * 32) = *reinterpret_cast<const bf16x8*>(Qw + (DQK / 16 - QL + d0) * 16);
    const int sr = tid >> 4, sc = (tid & 15) * 8, vst0 = v_st(sr, sc), vst1 = v_st(32 + sr, sc);
    const unsigned vo0 = (unsigned)(sr * ldv + sc), vo1 = vo0 + 32u * (unsigned)ldv;
    unsigned ko_[KPT]; int kw_[KPT];
#pragma unroll
    for (int i = 0; i < KPT; ++i) { const int c = tid + 512 * i, kr = c / NCH, kc = (c % NCH) * 8; ko_[i] = (unsigned)(kr * ldk + kc); kw_[i] = kr * KROW + kc * 2; }
    const int vb0 = (int)(unsigned)(uintptr_t)V_lds + v_rd_base(lane);
    const int qm = qpos0 + wid * QBLK + r32 + 128 - 4 * hi;
    struct Slot { bf16x8 vs0, vs1, ks[KPT]; };
    Slot sA, sB;
#define ATT_KB(j) ((j) < n0 ? s0 + 64 * (((j) + rot) >= n0 ? (j) + rot - n0 : (j) + rot) : s1 + 64 * ((j) - n0))
#define ATT_SLOAD(S, j) do { const int kb_ = ATT_KB(j); const bf16_t* vt_ = Vh + (size_t)kb_ * ldv; const bf16_t* kt_ = Kh + (size_t)kb_ * ldk; \
    S.vs0 = *reinterpret_cast<const bf16x8*>(vt_ + vo0); S.vs1 = *reinterpret_cast<const bf16x8*>(vt_ + vo1); \
    _Pragma("unroll") for (int i_ = 0; i_ < KPT; ++i_) S.ks[i_] = *reinterpret_cast<const bf16x8*>(kt_ + ko_[i_]); } while (0)
#define ATT_SWRITE(b, S) do { *reinterpret_cast<ATT_LAS bf16x8*>(V_lds + (b) * SHM_V + vst0) = S.vs0; *reinterpret_cast<ATT_LAS bf16x8*>(V_lds + (b) * SHM_V + vst1) = S.vs1; \
    _Pragma("unroll") for (int i_ = 0; i_ < KPT; ++i_) *reinterpret_cast<ATT_LAS bf16x8*>(K_lds + (b) * SHM_K + kw_[i_]) = S.ks[i_]; } while (0)
#define ATT_RESC(a) do { if (__any((a) < 1.f)) { if (hi == 0) al_l[r32] = (a); asm volatile("s_waitcnt lgkmcnt(0)" ::: "memory"); \
    _Pragma("unroll") for (int d = 0; d < 4; ++d) _Pragma("unroll") for (int r = 0; r < 16; ++r) o[d][r] *= al_l[crow(r, hi)]; } } while (0)
#define ATT_MASKT(P0_, P1_, j) do { if (MASK && (j) >= n0) mask_tile(P0_, P1_, qm - ATT_KB(j)); } while (0)
    f32x16 pA0, pA1, pB0, pB1; float mnA, mnB, alA, alB; bf16x8 pa0, pa1, pa2, pa3; const int NT = nt;
    ATT_SLOAD(sA, 0); asm volatile("s_waitcnt vmcnt(0)" ::: "memory"); ATT_SWRITE(0, sA); __syncthreads();
    qkt<DQK, QL>(pA0, pA1, K_lds, qr, Qs, r32, hi); ATT_MASKT(pA0, pA1, 0); partialSM(pA0, pA1, m_reg, mnA, alA);
    if constexpr (SD == 2) { ATT_SLOAD(sB, 1); ATT_SLOAD(sA, 2); ATT_SWRITE(1, sB); } else { ATT_SLOAD(sA, 1); ATT_SWRITE(1, sA); }
    __syncthreads();
    for (int j = 1; j + 1 < NT; j += 2) {
        ATT_SBAR(); qkt<DQK, QL>(pB0, pB1, K_lds + SHM_K, qr, Qs, r32, hi);
        finishSM(pA0, pA1, alA, l_reg, pa0, pa1, pa2, pa3); ATT_SBAR();
        if constexpr (SD == 2) { ATT_SLOAD(sB, j + 2); } else { ATT_SLOAD(sA, j + 1); }
        ATT_SBAR();
        pv_d0(o, vb0, pa0, pa1, pa2, pa3); ATT_MASKT(pB0, pB1, j); partialSM(pB0, pB1, m_reg, mnB, alB);
        __syncthreads(); ATT_SWRITE(0, sA);
        ATT_RESC(alB); __syncthreads();
        ATT_SBAR(); qkt<DQK, QL>(pA0, pA1, K_lds, qr, Qs, r32, hi);
        finishSM(pB0, pB1, alB, l_reg, pa0, pa1, pa2, pa3); ATT_SBAR();
        if constexpr (SD == 2) { if (j + 3 < NT) ATT_SLOAD(sA, j + 3); } else { ATT_SLOAD(sA, j + 2); }
        ATT_SBAR();
        pv_d0(o, vb0 + SHM_V, pa0, pa1, pa2, pa3); ATT_MASKT(pA0, pA1, j + 1); partialSM(pA0, pA1, m_reg, mnA, alA);
        __syncthreads(); if constexpr (SD == 2) { ATT_SWRITE(1, sB); } else { ATT_SWRITE(1, sA); }
        ATT_RESC(alA); __syncthreads();
    }
    ATT_SBAR(); qkt<DQK, QL>(pB0, pB1, K_lds + SHM_K, qr, Qs, r32, hi);
    finishSM(pA0, pA1, alA, l_reg, pa0, pa1, pa2, pa3); ATT_SBAR();
    pv_d0(o, vb0, pa0, pa1, pa2, pa3); ATT_MASKT(pB0, pB1, NT - 1); partialSM(pB0, pB1, m_reg, mnB, alB);
    __syncthreads(); ATT_RESC(alB);
    finishSM(pB0, pB1, alB, l_reg, pa0, pa1, pa2, pa3); ATT_SBAR();
    pv_d0(o, vb0 + SHM_V, pa0, pa1, pa2, pa3);
#undef ATT_KB
#undef ATT_SLOAD
#undef ATT_SWRITE
#undef ATT_RESC
#undef ATT_MASKT
}
template <int DQK, bool MASK, int PD>
__device__ __forceinline__ void attn_body_np(ATT_LAS unsigned char* lds, const bf16_t* __restrict__ Qb, int ldq, const bf16_t* __restrict__ Kh, int ldk,
                                             const bf16_t* __restrict__ Vh, int ldv, int nt, int n0, int s0, int s1, int qpos0, int rot,
                                             f32x16 (&o)[4], float& m_reg, float& l_reg) {
    constexpr int KROW = 2 * DQK + 16, SHM_K = 64 * KROW, NCH = DQK / 8, KPT = DQK / 64;
    const int tid = lid(), wid = __builtin_amdgcn_readfirstlane(tid >> 6), lane = tid & 63, r32 = lane & 31, hi = lane >> 5;
    ATT_LAS unsigned char* V_lds = lds; ATT_LAS unsigned char* K_lds = lds + 2 * SHM_V;
    ATT_LAS float* al_l = (ATT_LAS float*)(lds + 2 * SHM_V + 2 * SHM_K) + wid * 64 + 32;
    m_reg = -1e30f; l_reg = 0.f;
#pragma unroll
    for (int d = 0; d < 4; ++d) o[d] = f32x16{};
    bf16x8 qr[DQK / 16];
    const bf16_t* Qw = Qb + (size_t)(wid * QBLK + r32) * ldq + hi * 8;
#pragma unroll
    for (int d0 = 0; d0 < DQK / 16; ++d0) qr[d0] = *reinterpret_cast<const bf16x8*>(Qw + d0 * 16);
    const int sr = tid >> 4, sc = (tid & 15) * 8, vst0 = v_st(sr, sc), vst1 = v_st(32 + sr, sc);
    const unsigned vo0 = (unsigned)(sr * ldv + sc), vo1 = vo0 + 32u * (unsigned)ldv;
    unsigned ko_[KPT]; int kw_[KPT];
#pragma unroll
    for (int i = 0; i < KPT; ++i) { const int c = tid + 512 * i, kr = c / NCH, kc = (c % NCH) * 8; ko_[i] = (unsigned)(kr * ldk + kc); kw_[i] = kr * KROW + kc * 2; }
    const int vb0 = (int)(unsigned)(uintptr_t)V_lds + v_rd_base(lane);
    const int qm = qpos0 + wid * QBLK + r32 + 128 - 4 * hi;
    bf16x8 vs0[PD], vs1[PD], ks[PD][KPT];
#define ATT_KB(j) ((j) < n0 ? s0 + 64 * (((j) + rot) >= n0 ? (j) + rot - n0 : (j) + rot) : s1 + 64 * ((j) - n0))
#define ATT_SLOAD(S, j) do { const int kb_ = ATT_KB(j); const bf16_t* vt_ = Vh + (size_t)kb_ * ldv; const bf16_t* kt_ = Kh + (size_t)kb_ * ldk; \
    vs0[S] = *reinterpret_cast<const bf16x8*>(vt_ + vo0); vs1[S] = *reinterpret_cast<const bf16x8*>(vt_ + vo1); \
    _Pragma("unroll") for (int i_ = 0; i_ < KPT; ++i_) ks[S][i_] = *reinterpret_cast<const bf16x8*>(kt_ + ko_[i_]); } while (0)
#define ATT_SWRITE(b, S) do { *reinterpret_cast<ATT_LAS bf16x8*>(V_lds + (b) * SHM_V + vst0) = vs0[S]; *reinterpret_cast<ATT_LAS bf16x8*>(V_lds + (b) * SHM_V + vst1) = vs1[S]; \
    _Pragma("unroll") for (int i_ = 0; i_ < KPT; ++i_) *reinterpret_cast<ATT_LAS bf16x8*>(K_lds + (b) * SHM_K + kw_[i_]) = ks[S][i_]; } while (0)
#pragma unroll
    for (int d = 0; d < PD; ++d) if (d < nt) ATT_SLOAD(d, d);
    ATT_SWRITE(0, 0); __syncthreads();
    for (int j0 = 0; j0 < nt; j0 += PD) {
#pragma unroll
        for (int u = 0; u < PD; ++u) { const int j = j0 + u;
            if (j < nt) {
                const int buf = j & 1;
                if (j + PD < nt) ATT_SLOAD(u, j + PD);
                f32x16 p0, p1; float mn, al; bf16x8 pa0, pa1, pa2, pa3;
                ATT_SBAR();
                {   const ATT_LAS unsigned char* Ks = K_lds + buf * SHM_K;
                    p0 = f32x16{}; p1 = f32x16{};
#pragma unroll
                    for (int d0 = 0; d0 < DQK / 16; ++d0) { const int cb = (d0 * 16 + hi * 8) * 2;
                        const bf16x8 b0 = *reinterpret_cast<const ATT_LAS bf16x8*>(Ks + r32 * KROW + cb);
                        const bf16x8 b1 = *reinterpret_cast<const ATT_LAS bf16x8*>(Ks + (32 + r32) * KROW + cb);
                        p0 = __builtin_amdgcn_mfma_f32_32x32x16_bf16(b0, qr[d0], p0, 0, 0, 0);
                        p1 = __builtin_amdgcn_mfma_f32_32x32x16_bf16(b1, qr[d0], p1, 0, 0, 0);
                        if ((d0 & 3) == 3) ATT_SBAR(); } }
                if (MASK && j >= n0) mask_tile(p0, p1, qm - ATT_KB(j));
                partialSM(p0, p1, m_reg, mn, al);
                if (__any(al < 1.f)) { if (hi == 0) al_l[r32] = al; asm volatile("s_waitcnt lgkmcnt(0)" ::: "memory");
#pragma unroll
                    for (int d = 0; d < 4; ++d)
#pragma unroll
                        for (int r = 0; r < 16; ++r) o[d][r] *= al_l[crow(r, hi)]; }
                finishSM(p0, p1, al, l_reg, pa0, pa1, pa2, pa3); ATT_SBAR();
                pv_d0(o, vb0 + buf * SHM_V, pa0, pa1, pa2, pa3);
                if (j + 1 < nt) ATT_SWRITE(buf ^ 1, (u + 1) % PD);
                __syncthreads();
            } }
    }
#undef ATT_KB
#undef ATT_SLOAD
#undef ATT_SWRITE
}
template <int DQK, bool MASK, int PD>
__device__ __forceinline__ void attn_body_np2(ATT_LAS unsigned char* lds, const bf16_t* __restrict__ Qb, int ldq, const bf16_t* __restrict__ Kh, int ldk,
                                              const bf16_t* __restrict__ Vh, int ldv, int nt, int n0, int s0, int s1, int qpos0, int rot,
                                              f32x16 (&o)[4], float& m_reg, float& l_reg) {
    constexpr int KROW = 2 * DQK + 16, SHM_K = 64 * KROW, NCH = DQK / 8, KPT = DQK / 64;
    constexpr int BUFB = 2 * SHM_V + 2 * SHM_K;
    const int tid = lid(), wid = __builtin_amdgcn_readfirstlane(tid >> 6), lane = tid & 63, r32 = lane & 31, hi = lane >> 5;
    ATT_LAS float* al_l = (ATT_LAS float*)(lds + 2 * BUFB) + wid * 64 + 32;
    m_reg = -1e30f; l_reg = 0.f;
#pragma unroll
    for (int d = 0; d < 4; ++d) o[d] = f32x16{};
    bf16x8 qr[DQK / 16];
    const bf16_t* Qw = Qb + (size_t)(wid * QBLK + r32) * ldq + hi * 8;
#pragma unroll
    for (int d0 = 0; d0 < DQK / 16; ++d0) qr[d0] = *reinterpret_cast<const bf16x8*>(Qw + d0 * 16);
    const int sr = tid >> 4, sc = (tid & 15) * 8, vst0 = v_st(sr, sc), vst1 = v_st(32 + sr, sc);
    const unsigned vo0 = (unsigned)(sr * ldv + sc), vo1 = vo0 + 32u * (unsigned)ldv;
    unsigned ko_[KPT]; int kw_[KPT];
#pragma unroll
    for (int i = 0; i < KPT; ++i) { const int c = tid + 512 * i, kr = c / NCH, kc = (c % NCH) * 8; ko_[i] = (unsigned)(kr * ldk + kc); kw_[i] = kr * KROW + kc * 2; }
    const int vbl = (int)(unsigned)(uintptr_t)lds + v_rd_base(lane);
    const int qm = qpos0 + wid * QBLK + r32 + 128 - 4 * hi;
    bf16x8 vs0[PD][2], vs1[PD][2], ks[PD][2][KPT];
#define ATT_KB(j) ((j) < n0 ? s0 + 64 * (((j) + rot) >= n0 ? (j) + rot - n0 : (j) + rot) : s1 + 64 * ((j) - n0))
#define ATT_SLOAD(S, jj) do { _Pragma("unroll") for (int h_ = 0; h_ < 2; ++h_) { const int kb_ = ATT_KB((jj) + h_); const bf16_t* vt_ = Vh + (size_t)kb_ * ldv; const bf16_t* kt_ = Kh + (size_t)kb_ * ldk; \
    vs0[S][h_] = *reinterpret_cast<const bf16x8*>(vt_ + vo0); vs1[S][h_] = *reinterpret_cast<const bf16x8*>(vt_ + vo1); \
    _Pragma("unroll") for (int i_ = 0; i_ < KPT; ++i_) ks[S][h_][i_] = *reinterpret_cast<const bf16x8*>(kt_ + ko_[i_]); } } while (0)
#define ATT_SWRITE(b, S) do { _Pragma("unroll") for (int h_ = 0; h_ < 2; ++h_) { ATT_LAS unsigned char* vb_ = lds + (b) * BUFB + h_ * SHM_V; ATT_LAS unsigned char* kb2_ = lds + (b) * BUFB + 2 * SHM_V + h_ * SHM_K; \
    *reinterpret_cast<ATT_LAS bf16x8*>(vb_ + vst0) = vs0[S][h_]; *reinterpret_cast<ATT_LAS bf16x8*>(vb_ + vst1) = vs1[S][h_]; \
    _Pragma("unroll") for (int i_ = 0; i_ < KPT; ++i_) *reinterpret_cast<ATT_LAS bf16x8*>(kb2_ + kw_[i_]) = ks[S][h_][i_]; } } while (0)
    const int ns = nt / 2;
#pragma unroll
    for (int d = 0; d < PD; ++d) if (d < ns) ATT_SLOAD(d, 2 * d);
    ATT_SWRITE(0, 0); __syncthreads();
    for (int j0 = 0; j0 < ns; j0 += PD) {
#pragma unroll
        for (int u = 0; u < PD; ++u) { const int js = j0 + u;
            if (js < ns) {
                const int buf = js & 1;
                if (js + PD < ns) ATT_SLOAD(u, 2 * (js + PD));
#pragma unroll
                for (int h_ = 0; h_ < 2; ++h_) { const int j = 2 * js + h_;
                    f32x16 p0, p1; float mn, al; bf16x8 pa0, pa1, pa2, pa3;
                    ATT_SBAR();
                    {   const ATT_LAS unsigned char* Ks = lds + buf * BUFB + 2 * SHM_V + h_ * SHM_K;
                        p0 = f32x16{}; p1 = f32x16{};
#pragma unroll
                        for (int d0 = 0; d0 < DQK / 16; ++d0) { const int cb = (d0 * 16 + hi * 8) * 2;
                            const bf16x8 b0 = *reinterpret_cast<const ATT_LAS bf16x8*>(Ks + r32 * KROW + cb);
                            const bf16x8 b1 = *reinterpret_cast<const ATT_LAS bf16x8*>(Ks + (32 + r32) * KROW + cb);
                            p0 = __builtin_amdgcn_mfma_f32_32x32x16_bf16(b0, qr[d0], p0, 0, 0, 0);
                            p1 = __builtin_amdgcn_mfma_f32_32x32x16_bf16(b1, qr[d0], p1, 0, 0, 0);
                            if ((d0 & 3) == 3) ATT_SBAR(); } }
                    if (MASK && j >= n0) mask_tile(p0, p1, qm - ATT_KB(j));
                    partialSM(p0, p1, m_reg, mn, al);
                    if (__any(al < 1.f)) { if (hi == 0) al_l[r32] = al; asm volatile("s_waitcnt lgkmcnt(0)" ::: "memory");
#pragma unroll
                        for (int d = 0; d < 4; ++d)
#pragma unroll
                            for (int r = 0; r < 16; ++r) o[d][r] *= al_l[crow(r, hi)]; }
                    finishSM(p0, p1, al, l_reg, pa0, pa1, pa2, pa3); ATT_SBAR();
                    pv_d0(o, vbl + buf * BUFB + h_ * SHM_V, pa0, pa1, pa2, pa3);
                }
                if (js + 1 < ns) ATT_SWRITE(buf ^ 1, (u + 1) % PD);
                __syncthreads();
            } }
    }
#undef ATT_KB
#undef ATT_SLOAD
#undef ATT_SWRITE
}
}
#define LDS_TOTAL 147456
#define LDS_BAR_OFF 145408
#define LDS_TAB_OFF 145664
#define NPHASE 24

typedef float f32x4v __attribute__((ext_vector_type(4)));
__device__ __forceinline__ void ld8f(const bf16_t* p, float (&v)[8]) {
    const uint4 w = *(const uint4*)p; const unsigned u[4] = {w.x, w.y, w.z, w.w};
#pragma unroll
    for (int i = 0; i < 4; ++i) { v[2 * i] = __uint_as_float(u[i] << 16); v[2 * i + 1] = __uint_as_float(u[i] & 0xffff0000u); }
}
__device__ __forceinline__ void ld8g(const float* p, float (&v)[8]) {
    const f32x4v a = *(const f32x4v*)p, b = *(const f32x4v*)(p + 4);
    v[0] = a[0]; v[1] = a[1]; v[2] = a[2]; v[3] = a[3]; v[4] = b[0]; v[5] = b[1]; v[6] = b[2]; v[7] = b[3];
}
__device__ __forceinline__ void st8bf(bf16_t* p, const float (&v)[8]) {
    uint4 w; w.x = pg8::cvt_pk_bf16(v[0], v[1]); w.y = pg8::cvt_pk_bf16(v[2], v[3]); w.z = pg8::cvt_pk_bf16(v[4], v[5]); w.w = pg8::cvt_pk_bf16(v[6], v[7]);
    *(uint4*)p = w;
}

__device__ __forceinline__ void st8bf_nt(bf16_t* p, const float (&v)[8]) {
    typedef unsigned u32x4v __attribute__((ext_vector_type(4)));
    u32x4v w; w.x = pg8::cvt_pk_bf16(v[0], v[1]); w.y = pg8::cvt_pk_bf16(v[2], v[3]); w.z = pg8::cvt_pk_bf16(v[4], v[5]); w.w = pg8::cvt_pk_bf16(v[6], v[7]);
    __builtin_nontemporal_store(w, (u32x4v*)p);
}
struct CT { const float* src; bf16_t* dst; int ld, ldd; bool pad; };
#define NT_GU   (64 * 256)
#define NT_DN   (64 * 256)
#define NT_WIN  (2 * 32 * 64)
#define NT_WOUT (2 * 32 * 32)
#define NT_WUQ  (2 * 8 * 12)
#define NT_WUKV (2 * 4 * 16)
#define NT_CONV (2 * NT_GU + NT_DN + NT_WIN + NT_WOUT + NT_WUQ + NT_WUKV)
#define NJ_CONV (NT_CONV / 4)
#define NJ_MOE (3 * NT_GU / 4)
#define NJ_DENSE (NJ_CONV - NJ_MOE)
#define NWORK 224
__device__ __forceinline__ int moe_job_tile(int j) { const int l = j / 6144, r = j % 6144, kind = r >> 11, m = r & 2047;
    return kind * NT_GU + (l * 32 * 256) + m * 4; }
template <class PT> __device__ __forceinline__ CT conv_decode(const PT& p, const float* wg, const float* wu, const float* wd, int g) {
    CT c; c.pad = false;
    if (g < 2 * NT_GU) { const int up = g >= NT_GU; if (up) g -= NT_GU;
        const int mat = g >> 8, tl = g & 255, kt = tl >> 3, nt = tl & 7, n0 = nt * 64;
        c.src = (up ? wu : wg) + (size_t)mat * D_ * DEXP + (size_t)(kt * 64) * DEXP + n0; c.ld = DEXP;
        c.dst = p.guT() + ((size_t)mat * 1024 + (n0 >> 7) * 256 + up * 128 + (n0 & 127)) * D_ + kt * 64; c.ldd = D_; return c; }
    g -= 2 * NT_GU;
    if (g < NT_DN) { const int mat = g >> 8, tl = g & 255, kt = tl >> 5, nt = tl & 31;
        c.src = wd + (size_t)mat * DEXP * D_ + (size_t)(kt * 64) * D_ + nt * 64; c.ld = D_;
        c.dst = p.dT() + ((size_t)mat * D_ + nt * 64) * DEXP + kt * 64; c.ldd = DEXP; return c; }
    g -= NT_DN;
    if constexpr (!PT::HAS_FIELDS) { return c; } else {
    if (g < NT_WIN) { const int l = g >> 11, tl = g & 2047, kt = tl >> 6, nt = tl & 63;
        c.pad = nt >= 61;
        c.src = p.w_in + (size_t)l * D_ * DIN + (size_t)(kt * 64) * DIN + (c.pad ? 0 : nt * 64); c.ld = DIN;
        c.dst = p.winT() + ((size_t)l * ZLD + nt * 64) * D_ + kt * 64; c.ldd = D_; return c; }
    g -= NT_WIN;
    if (g < NT_WOUT) { const int l = g >> 10, tl = g & 1023, kt = tl >> 5, nt = tl & 31;
        c.src = p.w_out + (size_t)l * D_ * D_ + (size_t)(kt * 64) * D_ + nt * 64; c.ld = D_;
        c.dst = p.woutT() + ((size_t)l * D_ + nt * 64) * D_ + kt * 64; c.ldd = D_; return c; }
    g -= NT_WOUT;
    if (g < NT_WUQ) { const int l = g / 96, tl = g % 96, kt = tl / 12, nt = tl % 12;
        c.src = p.c_wuq + (size_t)l * 512 * 768 + (size_t)(kt * 64) * 768 + nt * 64; c.ld = 768;
        c.dst = p.wuqT() + ((size_t)l * 768 + nt * 64) * 512 + kt * 64; c.ldd = 512; return c; }
    g -= NT_WUQ;
    { const int l = g >> 6, tl = g & 63, kt = tl >> 4, nt = tl & 15;
        c.src = p.c_wukv + (size_t)l * 256 * 1024 + (size_t)(kt * 64) * 1024 + nt * 64; c.ld = 1024;
        c.dst = p.wukvT() + ((size_t)l * 1024 + nt * 64) * 256 + kt * 64; c.ldd = 256; return c; }
    }
}
template <bool NT, class PT, class F> __device__ __forceinline__ void conv_pipe(const PT& p, const float* wg, const float* wu, const float* wd, int n, F tile_of, LAS float* T, int tid) {
    if (n <= 0) return;
    f32x4v a0[4], b0[4], a1[4], b1[4], a2[4], b2[4];
    const int kl = tid >> 3, nc = (tid & 7) * 8;
#define CONV_LOAD(A_, B_, g0_) do { _Pragma("unroll") for (int t = 0; t < 4; ++t) { const CT c = conv_decode(p, wg, wu, wd, (g0_) + t); \
        const float* sp = c.src + (size_t)kl * c.ld + nc; const f32x4v z4 = (f32x4v){0.f, 0.f, 0.f, 0.f}; \
        f32x4v la = z4, lb = z4; if (!c.pad) { if (NT) { la = __builtin_nontemporal_load((const f32x4v*)sp); lb = __builtin_nontemporal_load((const f32x4v*)(sp + 4)); } else { la = *(const f32x4v*)sp; lb = *(const f32x4v*)(sp + 4); } } A_[t] = la; B_[t] = lb; } } while (0)
#define CONV_STEP(A_, B_, k_) do { \
        _Pragma("unroll") for (int t = 0; t < 4; ++t) { LAS float* tp = T + t * (64 * 65) + kl * 65 + nc; \
            tp[0] = A_[t][0]; tp[1] = A_[t][1]; tp[2] = A_[t][2]; tp[3] = A_[t][3]; tp[4] = B_[t][0]; tp[5] = B_[t][1]; tp[6] = B_[t][2]; tp[7] = B_[t][3]; } \
        __syncthreads(); \
        const int g0s = tile_of(k_); \
        if ((k_) + 3 < n) CONV_LOAD(A_, B_, tile_of((k_) + 3)); \
        {   const int nn = tid >> 3, kc = (tid & 7) * 8; \
            _Pragma("unroll") for (int t = 0; t < 4; ++t) { const CT c = conv_decode(p, wg, wu, wd, g0s + t); float v[8]; \
                _Pragma("unroll") for (int i = 0; i < 8; ++i) v[i] = T[t * (64 * 65) + (kc + i) * 65 + nn]; \
                if (NT) st8bf_nt(c.dst + (size_t)nn * c.ldd + kc, v); else st8bf(c.dst + (size_t)nn * c.ldd + kc, v); } } \
        __syncthreads(); } while (0)
    CONV_LOAD(a0, b0, tile_of(0));
    if (1 < n) CONV_LOAD(a1, b1, tile_of(1));
    if (2 < n) CONV_LOAD(a2, b2, tile_of(2));
    for (int k = 0; k < n; k += 3) {
        CONV_STEP(a0, b0, k);
        if (k + 1 < n) CONV_STEP(a1, b1, k + 1);
        if (k + 2 < n) CONV_STEP(a2, b2, k + 2);
    }
#undef CONV_LOAD
#undef CONV_STEP
}
__device__ __forceinline__ void ph_prologue(const P& p, LAS unsigned char* lds, int bid, int nb) {
    const int tid = lid();
    for (int i = bid * 512 + tid; i < 2048 * 64; i += nb * 512) {
        const int t = i >> 6, j = i & 63; const float r = (float)(t >> 6), col = (float)(t & 63);
        if (j < 32) { const float inv = powf(10000.0f, -(float)(j & 15) / 16.0f), ang = (j < 16 ? r : col) * inv; p.cosA()[t * 32 + j] = cosf(ang); p.sinA()[t * 32 + j] = sinf(ang); }
        { const float inv = powf(10000.0f, -(float)(j & 31) / 32.0f), ang = (j < 32 ? r : col) * inv; p.cosB()[t * 64 + j] = cosf(ang); p.sinB()[t * 64 + j] = sinf(ang); }
    }
    for (int i = bid * 512 + tid; i < 2048 * 32; i += nb * 512) { const int k = i >> 5, e = i & 31; const float w = p.router_w[i];
        const bf16_t hi = f2bf(w); const bf16_t lo = f2bf(w - bf2f(hi)); p.rwT()[(size_t)e * 2048 + k] = hi; p.rwT()[(size_t)(32 + e) * 2048 + k] = lo; }
    for (int tile = bid; tile < 192; tile += nb) {
        LAS float* s = (LAS float*)lds;
        LAS float* red = s + 5 * D_;
        __syncthreads();
        for (int i = tid; i < 5 * D_; i += 512) { const int r = i >> 11, k = i & 2047; const float v = r < 4 ? p.c[r * D_ + k] : p.c_ctx[k]; s[i] = v / (1.0f + __expf(-v)); }
        __syncthreads();
        const int l = tile / 96, n0 = (tile % 96) * 128, cl = tid & 31, kg = tid >> 5;
        const float* w = p.ada_w + (size_t)l * D_ * 6 * D_ + (size_t)(kg * 128) * 6 * D_ + n0 + cl * 4;
        f32x4v acc[5];
#pragma unroll
        for (int r = 0; r < 5; ++r) acc[r] = (f32x4v){0.f, 0.f, 0.f, 0.f};
#pragma unroll 8
        for (int k = 0; k < 128; ++k) { const f32x4v wv = *(const f32x4v*)(w + (size_t)k * 6 * D_);
#pragma unroll
            for (int r = 0; r < 5; ++r) acc[r] += wv * s[r * D_ + kg * 128 + k]; }
#pragma unroll
        for (int r = 0; r < 5; ++r) *(LAS f32x4v*)(red + (kg * 5 + r) * 128 + cl * 4) = acc[r];
        __syncthreads();
        for (int idx = tid; idx < 640; idx += 512) { const int r = idx >> 7, cc = idx & 127; float sum = p.ada_b[l * 6 * D_ + n0 + cc];
#pragma unroll
            for (int g2 = 0; g2 < 16; ++g2) sum += red[(g2 * 5 + r) * 128 + cc];
            p.mod()[((size_t)(l * 5 + r)) * 6 * D_ + n0 + cc] = sum; }
        __syncthreads();
    }
    LAS float* T = (LAS float*)lds;
    conv_pipe<false>(p, p.moe_w_gate, p.moe_w_up, p.moe_w_down, (NJ_DENSE - bid + nb - 1) / nb, [&](int k) { return 3 * NT_GU + (bid + k * nb) * 4; }, T, tid);
}
#ifndef NW_IN
#define NW_IN 192
#endif
#ifndef NW_OUT
#define NW_OUT 144
#endif
#ifndef NW_GU
#define NW_GU 208
#endif
__device__ __forceinline__ void bg_window(const Q& p, LAS unsigned char* lds, int ph, int nwork, int lq) {
    const int tid = lid();
    LAS int* jb = (LAS int*)(lds + LDS_TAB_OFF + 1024);
    LAS float* T = (LAS float*)lds;
    const float* wg = p.moe_w_gate(); const float* wu = p.moe_w_up(); const float* wd = p.moe_w_down();
    __syncthreads();
    for (;;) {
        if (tid == 0) { int j = -1;
            if (__hip_atomic_load(p.pdone(ph), __ATOMIC_RELAXED, __HIP_MEMORY_SCOPE_AGENT) < nwork) {
                for (int qq = lq; qq < 2 && j < 0; ++qq) {
                    if (__hip_atomic_load(p.qhead() + qq * 16, __ATOMIC_RELAXED, __HIP_MEMORY_SCOPE_AGENT) >= 6144) continue;
                    const int c = __hip_atomic_fetch_add(p.qhead() + qq * 16, 4, __ATOMIC_RELAXED, __HIP_MEMORY_SCOPE_AGENT);
                    if (c < 6144) j = qq * 6144 + c; } }
            jb[0] = j; }
        __syncthreads();
        const int j = jb[0];
        if (j < 0) break;
        conv_pipe<false>(p, wg, wu, wd, 4, [&](int k) { return moe_job_tile(j + k); }, T, tid);
    }
    __syncthreads();
}
__device__ __forceinline__ void bg_drain(const Q& p, LAS unsigned char* lds, int lq, int bid, int nb) {
    const int tid = lid();
    LAS float* T = (LAS float*)lds;
    const float* wg = p.moe_w_gate(); const float* wu = p.moe_w_up(); const float* wd = p.moe_w_down();
    int head = __builtin_amdgcn_readfirstlane(__hip_atomic_load(p.qhead() + lq * 16, __ATOMIC_RELAXED, __HIP_MEMORY_SCOPE_AGENT));
    if (head > 6144) head = 6144;
    __syncthreads();
    conv_pipe<false>(p, wg, wu, wd, (6144 - head - bid + nb - 1) / nb, [&](int k) { return moe_job_tile(lq * 6144 + head + bid + k * nb); }, T, tid);
}
__device__ __forceinline__ void worker_done(const Q& p, int ph) {
    __syncthreads();
    if (lid() == 0) __hip_atomic_fetch_add(p.pdone(ph), 1, __ATOMIC_RELAXED, __HIP_MEMORY_SCOPE_AGENT);
}

__device__ __forceinline__ int slot_offsets(const int* cnt, int lane, int& total) {
    int v = lane < 32 ? ((cnt[(lane & 31) * CNT_STRIDE] + 255) & ~255) : 0;
    int inc = v;
#pragma unroll
    for (int o = 1; o < 32; o <<= 1) { const int t = bperm_i(inc, lane - o); if ((lane & 31) >= o) inc += t; }
    total = bperm_i(inc, 31);
    return inc - v;
}

__device__ __forceinline__ f32x4v bf4_to_f32(const uint2 a) { f32x4v r; r[0] = __uint_as_float(a.x << 16); r[1] = __uint_as_float(a.x & 0xffff0000u); r[2] = __uint_as_float(a.y << 16); r[3] = __uint_as_float(a.y & 0xffff0000u); return r; }
struct RowMeta { int e0, e1, p0, p1; float w0, w1; };
__device__ __forceinline__ void ph_rows_norm1(const Q& p, int lc  , int ln  , const float* src_lat, const float* src_ctx, int bid, int nb) {
    const int tid = lid(), lane = tid & 63, gw = __builtin_amdgcn_readfirstlane(bid * 8 + (tid >> 6)), nw = nb * 8;
    int offs = 0, total = 0;
    if (lc >= 0) offs = slot_offsets(p.cnt() + lc * 32 * CNT_STRIDE, lane, total);
    const bool skipctx = (ln < 0) || (lc == 1);
    const int* tke = p.tok_e(); const int* tkp = p.tok_pos(); const float* tkw = p.tok_w();
    auto active = [&](int R) { return R < NR && !(skipctx && (R % TPB) >= SEQ); };
    auto xoff_of = [&](int R) { const int b = R / TPB, t = R % TPB; return t < SEQ ? ((size_t)b * SEQ + t) * D_ : ((size_t)b * CTXL + (t - SEQ)) * D_; };
    auto load_row = [&](int R, f32x4v (&xv)[8], RowMeta& m) {
        const float* src = ((R % TPB) < SEQ ? src_lat : src_ctx) + xoff_of(R);
#pragma unroll
        for (int i = 0; i < 8; ++i) xv[i] = *(const f32x4v*)(src + (i * 64 + lane) * 4);
        if (lc >= 0) { m.e0 = tke[R * 2]; m.e1 = tke[R * 2 + 1]; m.p0 = tkp[R * 2]; m.p1 = tkp[R * 2 + 1]; m.w0 = tkw[R * 2]; m.w1 = tkw[R * 2 + 1]; }
    };
    int R = gw; f32x4v xv[8]; RowMeta mt{}; bool hv = active(R);
    if (hv) load_row(R, xv, mt);
    for (; R < NR; R += nw) {
        const int Rn = R + nw; f32x4v xn[8]; RowMeta mn{}; const bool hn = active(Rn);
        if (hn) load_row(Rn, xn, mn);
        if (hv) {
            const int b = R / TPB, t = R % TPB; const bool lat = t < SEQ; const size_t xoff = xoff_of(R);
            if (lc >= 0) {
                const int s0 = bperm_i(offs, mt.e0) + mt.p0, s1 = bperm_i(offs, mt.e1) + mt.p1;
                const float w0 = mt.w0, w1 = mt.w1;
                const float* g2 = p.mod() + ((size_t)(lc * 5 + (lat ? b : 4))) * 6 * D_ + 5 * D_;
                const bf16_t* y0 = p.yslot() + (size_t)s0 * D_; const bf16_t* y1 = p.yslot() + (size_t)s1 * D_;
                float* dst = (lat ? p.xw : p.xc()) + xoff;
                uint2 ya_[8], yb_[8];
                const bf16_t* dl = p.dbuf() + (size_t)R * D_;
#pragma unroll
                for (int i = 0; i < 8; ++i) { const int k = (i * 64 + lane) * 4; ya_[i] = *(const uint2*)(y0 + k); yb_[i] = *(const uint2*)(y1 + k); xv[i] = xv[i] + bf4_to_f32(*(const uint2*)(dl + k)); }
#pragma unroll
                for (int i = 0; i < 8; ++i) { const int k = (i * 64 + lane) * 4;
                    const uint2 a = ya_[i], c = yb_[i]; const f32x4v gv = *(const f32x4v*)(g2 + k);
                    f32x4v ya, yb;
                    ya[0] = __uint_as_float(a.x << 16); ya[1] = __uint_as_float(a.x & 0xffff0000u); ya[2] = __uint_as_float(a.y << 16); ya[3] = __uint_as_float(a.y & 0xffff0000u);
                    yb[0] = __uint_as_float(c.x << 16); yb[1] = __uint_as_float(c.x & 0xffff0000u); yb[2] = __uint_as_float(c.y << 16); yb[3] = __uint_as_float(c.y & 0xffff0000u);
                    xv[i] = xv[i] + gv * (ya * w0 + yb * w1);
                    *(f32x4v*)(dst + k) = xv[i]; }
            }
            if (ln >= 0) {
                float ss = 0.f;
#pragma unroll
                for (int i = 0; i < 8; ++i) ss += xv[i][0] * xv[i][0] + xv[i][1] * xv[i][1] + xv[i][2] * xv[i][2] + xv[i][3] * xv[i][3];
                ss = wave_sum(ss);
                const float rstd = rsqrtf(ss / D_ + EPS);
                const float* md = p.mod() + ((size_t)(ln * 5 + (lat ? b : 4))) * 6 * D_;
                const float* g = p.norm1_g() + ln * D_;
#pragma unroll
                for (int i = 0; i < 8; ++i) { const int k = (i * 64 + lane) * 4;
                    const f32x4v gv = *(const f32x4v*)(g + k), sc = *(const f32x4v*)(md + D_ + k), sh = *(const f32x4v*)(md + k);
                    const f32x4v h = xv[i] * rstd * gv * (sc + 1.0f) + sh;
                    uint2 w; w.x = pg8::cvt_pk_bf16(h[0], h[1]); w.y = pg8::cvt_pk_bf16(h[2], h[3]);
                    *(uint2*)(p.hbuf() + (size_t)R * D_ + k) = w; }
            }
        }
#pragma unroll
        for (int i = 0; i < 8; ++i) xv[i] = xn[i];
        mt = mn; hv = hn;
    }
}

__device__ __forceinline__ void up8(const uint4 w, float (&v)[8]) {
    const unsigned u[4] = {w.x, w.y, w.z, w.w};
#pragma unroll
    for (int i = 0; i < 4; ++i) { v[2 * i] = __uint_as_float(u[i] << 16); v[2 * i + 1] = __uint_as_float(u[i] & 0xffff0000u); }
}
template <int SEGL> __device__ __forceinline__ void seg_nr(float (&v)[8], const float (&g)[8], bool rope, const f32x4v c0, const f32x4v c1, const f32x4v s0, const f32x4v s1, int lane, float scale) {
    float ss = 0.f;
#pragma unroll
    for (int i = 0; i < 8; ++i) ss += v[i] * v[i];
    ss = grp_sum<SEGL>(ss);
    const float r = rsqrtf(ss / (float)(SEGL * 8) + EPS);
#pragma unroll
    for (int i = 0; i < 8; ++i) v[i] = v[i] * r * g[i];
    if (rope) {
        const float c[8] = {c0[0], c0[1], c0[2], c0[3], c1[0], c1[1], c1[2], c1[3]}, s[8] = {s0[0], s0[1], s0[2], s0[3], s1[0], s1[1], s1[2], s1[3]};
        const bool upper = (lane & (SEGL / 2)) != 0;
#pragma unroll
        for (int i = 0; i < 8; ++i) { const float pr = shx(v[i], SEGL / 2); v[i] = upper ? pr * s[i] + v[i] * c[i] : v[i] * c[i] - pr * s[i]; }
    }
#pragma unroll
    for (int i = 0; i < 8; ++i) v[i] *= scale;
}
struct P1Row { uint4 z[8]; f32x4v cs[8]; };
__device__ __forceinline__ void ph_post1(const Q& p, int l, int bid, int nb) {
    const int tid = lid(), lane = tid & 63, gw = __builtin_amdgcn_readfirstlane(bid * 8 + (tid >> 6)), nw = nb * 8;
    const float scaleA = 0.125f * LOG2E, scaleB = 0.08838834764831845f * LOG2E;
    float gAq[8], gAk[8], gBq[8], gBk[8], gCq[8], gCkv[8], gCkr[8];
    ld8g(p.a_qn() + l * 64 + (lane & 7) * 8, gAq); ld8g(p.a_kn() + l * 64 + (lane & 7) * 8, gAk);
    ld8g(p.b_qn() + l * 128 + (lane & 15) * 8, gBq); ld8g(p.b_kn() + l * 128 + (lane & 15) * 8, gBk);
    ld8g(p.c_qa_norm() + l * 512 + lane * 8, gCq); ld8g(p.c_kva_norm() + l * 256 + (lane & 31) * 8, gCkv); ld8g(p.c_kn() + l * 192 + 128 + (lane & 7) * 8, gCkr);
    const bf16_t* zb = p.z(); const float* cA = p.cosA(); const float* sA = p.sinA(); const float* cB = p.cosB(); const float* sB = p.sinB();
    auto load_row = [&](int R, P1Row& d) {
        const int t = R % TPB; const int tt = t < SEQ ? t : 0;
        const bf16_t* zr = zb + (size_t)R * ZLD;
        d.z[0] = *(const uint4*)(zr + lane * 8); d.z[1] = *(const uint4*)(zr + 512 + lane * 8);
        d.z[2] = *(const uint4*)(zr + 1536 + lane * 8); d.z[3] = *(const uint4*)(zr + 2048 + lane * 8);
        d.z[4] = *(const uint4*)(zr + 2560 + (lane & 31) * 8); d.z[5] = *(const uint4*)(zr + 3072 + lane * 8);
        d.z[6] = *(const uint4*)(zr + 3584 + (lane & 31) * 8); d.z[7] = *(const uint4*)(zr + 3840 + (lane & 7) * 8);
        const int jA = tt * 32 + (lane & 3) * 8, jB = tt * 64 + (lane & 7) * 8;
        d.cs[0] = *(const f32x4v*)(cA + jA); d.cs[1] = *(const f32x4v*)(cA + jA + 4); d.cs[2] = *(const f32x4v*)(sA + jA); d.cs[3] = *(const f32x4v*)(sA + jA + 4);
        d.cs[4] = *(const f32x4v*)(cB + jB); d.cs[5] = *(const f32x4v*)(cB + jB + 4); d.cs[6] = *(const f32x4v*)(sB + jB); d.cs[7] = *(const f32x4v*)(sB + jB + 4);
    };
    int R = gw; P1Row cur; if (R < NR) load_row(R, cur);
    for (; R < NR; R += nw) {
        const int Rn = R + nw; P1Row nxt; if (Rn < NR) load_row(Rn, nxt); else nxt = cur;
        const bool lat = (R % TPB) < SEQ;
        float v[8];
        up8(cur.z[0], v); seg_nr<8>(v, gAq, lat, cur.cs[0], cur.cs[1], cur.cs[2], cur.cs[3], lane, scaleA); st8bf(p.QA() + (size_t)R * 512 + lane * 8, v);
        up8(cur.z[1], v); seg_nr<8>(v, gAk, lat, cur.cs[0], cur.cs[1], cur.cs[2], cur.cs[3], lane, 1.0f); st8bf(p.KA() + (size_t)R * 512 + lane * 8, v);
        up8(cur.z[2], v); seg_nr<16>(v, gBq, lat, cur.cs[4], cur.cs[5], cur.cs[6], cur.cs[7], lane, scaleB); st8bf(p.QB() + (size_t)R * 1024 + lane * 8, v);
        up8(cur.z[3], v); seg_nr<16>(v, gBq, lat, cur.cs[4], cur.cs[5], cur.cs[6], cur.cs[7], lane, scaleB); st8bf(p.QB() + (size_t)R * 1024 + 512 + lane * 8, v);
        up8(cur.z[4], v); seg_nr<16>(v, gBk, lat, cur.cs[4], cur.cs[5], cur.cs[6], cur.cs[7], lane, 1.0f); if (lane < 32) st8bf(p.KB() + (size_t)R * 256 + lane * 8, v);
        up8(cur.z[5], v); seg_nr<64>(v, gCq, false, cur.cs[0], cur.cs[1], cur.cs[2], cur.cs[3], lane, 1.0f); st8bf(p.cqn() + (size_t)R * 512 + lane * 8, v);
        up8(cur.z[6], v); seg_nr<32>(v, gCkv, false, cur.cs[0], cur.cs[1], cur.cs[2], cur.cs[3], lane, 1.0f); if (lane < 32) st8bf(p.ckvn() + (size_t)R * 256 + lane * 8, v);
        up8(cur.z[7], v); seg_nr<8>(v, gCkr, lat, cur.cs[0], cur.cs[1], cur.cs[2], cur.cs[3], lane, 1.0f); if (lane < 8) st8bf(p.krope() + (size_t)R * 64 + lane * 8, v);
        cur = nxt;
    }
}
struct P2Row { uint4 qn, kn, qr, kr; f32x4v cs[4]; };
__device__ __forceinline__ void ph_post2(const Q& p, int l, int bid, int nb) {
    const int tid = lid(), lane = tid & 63, gw = __builtin_amdgcn_readfirstlane(bid * 8 + (tid >> 6)), nw = nb * 8;
    const float scaleC = 0.07216878364870323f * LOG2E;
    const int h4 = lane >> 4, d16 = (lane & 15) * 8, h8 = (lane & 31) >> 3, d8 = (lane & 7) * 8;
    float gQn[8], gKn[8], gQr[8];
    ld8g(p.c_qn() + l * 192 + d16, gQn); ld8g(p.c_kn() + l * 192 + d16, gKn); ld8g(p.c_qn() + l * 192 + 128 + d8, gQr);
    const bf16_t* q2 = p.q2(); const bf16_t* kv2 = p.kv2(); const bf16_t* krp = p.krope(); const float* cA = p.cosA(); const float* sA = p.sinA();
    auto load_row = [&](int R, P2Row& d) {
        const int t = R % TPB; const int tt = t < SEQ ? t : 0;
        d.qn = *(const uint4*)(q2 + (size_t)R * 768 + h4 * 192 + d16); d.kn = *(const uint4*)(kv2 + (size_t)R * 1024 + h4 * 256 + d16);
        d.qr = *(const uint4*)(q2 + (size_t)R * 768 + h8 * 192 + 128 + d8); d.kr = *(const uint4*)(krp + (size_t)R * 64 + d8);
        const int jA = tt * 32 + (lane & 3) * 8;
        d.cs[0] = *(const f32x4v*)(cA + jA); d.cs[1] = *(const f32x4v*)(cA + jA + 4); d.cs[2] = *(const f32x4v*)(sA + jA); d.cs[3] = *(const f32x4v*)(sA + jA + 4);
    };
    int R = gw; P2Row cur; if (R < NR) load_row(R, cur);
    for (; R < NR; R += nw) {
        const int Rn = R + nw; P2Row nxt; if (Rn < NR) load_row(Rn, nxt); else nxt = cur;
        const bool lat = (R % TPB) < SEQ;
        float v[8];
        up8(cur.qn, v); seg_nr<16>(v, gQn, false, cur.cs[0], cur.cs[1], cur.cs[2], cur.cs[3], lane, scaleC); st8bf(p.QC() + (size_t)R * 768 + h4 * 192 + d16, v);
        up8(cur.kn, v); seg_nr<16>(v, gKn, false, cur.cs[0], cur.cs[1], cur.cs[2], cur.cs[3], lane, 1.0f); st8bf(p.KC() + (size_t)R * 768 + h4 * 192 + d16, v);
        up8(cur.qr, v); seg_nr<8>(v, gQr, lat, cur.cs[0], cur.cs[1], cur.cs[2], cur.cs[3], lane, scaleC);
        if (lane < 32) { st8bf(p.QC() + (size_t)R * 768 + h8 * 192 + 128 + d8, v); *(uint4*)(p.KC() + (size_t)R * 768 + h8 * 192 + 128 + d8) = cur.kr; }
        cur = nxt;
    }
}

template <int DQK> __device__ __forceinline__ LAS float* att_scratch(LAS unsigned char* lds, int wid) { return (LAS float*)(lds + 2 * att::SHM_V + 2 * 64 * (2 * DQK + 16)) + wid * 64; }
__device__ __forceinline__ void att_rli(LAS float* li_l, float l_reg, int r32, int hi, float (&rli)[16]) {
    if (hi == 0) li_l[r32] = l_reg;
    asm volatile("s_waitcnt lgkmcnt(0)" ::: "memory");
#pragma unroll
    for (int r = 0; r < 16; ++r) rli[r] = __builtin_amdgcn_rcpf(li_l[att::crow(r, hi)]);
}
__device__ __forceinline__ void att_store(bf16_t* Ob  , const att::f32x16 (&o)[4], const float (&rli)[16], int r32, int hi) {
#pragma unroll
    for (int r = 0; r < 16; ++r) { bf16_t* rp = Ob + (size_t)att::crow(r, hi) * D_ + r32;
#pragma unroll
        for (int d0 = 0; d0 < 4; ++d0) rp[d0 * 32] = f2bf(o[d0][r] * rli[r]); }
}
__device__ __forceinline__ void unit_A(const Q& p, int l, LAS unsigned char* lds, int b, int h, int qrow0, int nt, int s0, float lam, float lam_init, int bid) {
    const int rot = nt >= 36 ? ((qrow0 >> 8) * 9 / 2) * 1 : 0;
    const int tid = lid(), wid = __builtin_amdgcn_readfirstlane(tid >> 6), lane = tid & 63, r32 = lane & 31, hi = lane >> 5;
    const size_t rb = (size_t)b * TPB;
    att::f32x16 o[4]; float m_reg, l_reg; float rli[16];
    float* scr = p.oscr() + (size_t)bid * 256 * 128 + (size_t)(wid * 32) * 128 + (4 * hi * 128 + r32);
    LAS float* li_l = (LAS float*)(lds + 2 * (2 * att::SHM_V + 2 * 64 * 144)) + wid * 64;
    __syncthreads();
    att::attn_body_np2<64, false, 1>(lds, p.QA() + (rb + qrow0) * 512 + h * 128, 512, p.KA() + rb * 512 + h * 128, 512, p.z() + rb * ZLD + 1024 + h * 128, ZLD, nt, nt, s0, 0, 0, rot, o, m_reg, l_reg);
    att_rli(li_l, l_reg, r32, hi, rli);
#pragma unroll
    for (int r = 0; r < 16; ++r)
#pragma unroll
        for (int d0 = 0; d0 < 4; ++d0) scr[((r & 3) + 8 * (r >> 2)) * 128 + d0 * 32] = o[d0][r] * rli[r];
    __syncthreads();
    att::attn_body_np2<64, false, 1>(lds, p.QA() + (rb + qrow0) * 512 + h * 128 + 64, 512, p.KA() + rb * 512 + h * 128 + 64, 512, p.z() + rb * ZLD + 1024 + h * 128, ZLD, nt, nt, s0, 0, 0, rot, o, m_reg, l_reg);
    att_rli(li_l, l_reg, r32, hi, rli);
    asm volatile("" : "+v"(scr));
    float ss[16];
#pragma unroll
    for (int r = 0; r < 16; ++r) { ss[r] = 0.f;
#pragma unroll
        for (int d0 = 0; d0 < 4; ++d0) { const float v = scr[((r & 3) + 8 * (r >> 2)) * 128 + d0 * 32] - lam * (o[d0][r] * rli[r]); o[d0][r] = v; ss[r] += v * v; } }
#pragma unroll
    for (int r = 0; r < 16; ++r) { float s = ss[r];
#pragma unroll
        for (int of = 16; of >= 1; of >>= 1) s += shx(s, of);
        rli[r] = rsqrtf(s / 128.0f + EPS) * (1.0f - lam_init); }
    const float* sg = p.a_subln() + l * 128;
    float sgv[4];
#pragma unroll
    for (int d0 = 0; d0 < 4; ++d0) sgv[d0] = sg[d0 * 32 + r32];
#pragma unroll
    for (int d0 = 0; d0 < 4; ++d0)
#pragma unroll
        for (int r = 0; r < 16; ++r) o[d0][r] *= sgv[d0];
    att_store(p.mix() + (rb + qrow0 + wid * 32) * D_ + h * 128, o, rli, r32, hi);
}
__device__ __forceinline__ void unit_B(const Q& p, int l, LAS unsigned char* lds, int b, int h, int qrow0, bool ctxq) {
    const int tid = lid(), wid = __builtin_amdgcn_readfirstlane(tid >> 6), lane = tid & 63, r32 = lane & 31, hi = lane >> 5;
    const size_t rb = (size_t)b * TPB; const int kvh = h >> 2;
    att::f32x16 o[4]; float m_reg, l_reg; float rli[16];
    int nt = 4, s1 = 0;
    if (!ctxq) { const int kl0 = qrow0 >= 128 ? qrow0 - 128 : 0, kl1 = qrow0 + 384 <= SEQ ? qrow0 + 384 : SEQ; nt = 4 + (kl1 - kl0) / 64; s1 = kl0; }
    __syncthreads();
    att::attn_body_np2<128, true, 1>(lds, p.QB() + (rb + qrow0) * 1024 + h * 128, 1024, p.KB() + rb * 256 + kvh * 128, 256, p.z() + rb * ZLD + 2816 + kvh * 128, ZLD, nt, 4, SEQ, s1, qrow0, 0, o, m_reg, l_reg);
    l_reg += __builtin_amdgcn_exp2f(p.b_sink()[l * 8 + h] * LOG2E - m_reg);
    att_rli((LAS float*)(lds + 2 * (2 * att::SHM_V + 2 * 64 * 272)) + wid * 64, l_reg, r32, hi, rli);
    att_store(p.mix() + (rb + qrow0 + wid * 32) * D_ + 512 + h * 128, o, rli, r32, hi);
}
__device__ __forceinline__ void unit_C(const Q& p, LAS unsigned char* lds, int b, int h, int qrow0, int nt, int s0) {
    const int tid = lid(), wid = __builtin_amdgcn_readfirstlane(tid >> 6), lane = tid & 63, r32 = lane & 31, hi = lane >> 5;
    const size_t rb = (size_t)b * TPB;
    att::f32x16 o[4]; float m_reg, l_reg; float rli[16];
    __syncthreads();
    att::attn_body_np<192, false, 2>(lds, p.QC() + (rb + qrow0) * 768 + h * 192, 768, p.KC() + rb * 768 + h * 192, 768, p.kv2() + rb * 1024 + h * 256 + 128, 1024, nt, nt, s0, 0, 0, nt >= 36 ? ((qrow0 >> 8) * 9 / 2) : 0, o, m_reg, l_reg);
    att_rli(att_scratch<192>(lds, wid), l_reg, r32, hi, rli);
    att_store(p.mix() + (rb + qrow0 + wid * 32) * D_ + 1536 + h * 128, o, rli, r32, hi);
}
__device__ __forceinline__ void ph_attn(const Q& p, int l, LAS unsigned char* lds, int bid, int nb) {
    const int lane = lid() & 63;
    const float* lv = p.a_lambda() + l * 256;
    const float s01 = wave_sum(lv[lane] * lv[64 + lane]), s23 = wave_sum(lv[128 + lane] * lv[192 + lane]);
    const float lam_init = 0.8f - 0.6f * expf(-0.3f * (float)l), lam = expf(s01) - expf(s23) + lam_init;
    for (int i = bid; i < 256; i += nb) {
        const int xcd = i & 7;
        if (i < 128) { const int slot = i >> 3, bh = xcd * 2 + (slot >> 3); unit_A(p, l, lds, bh >> 2, bh & 3, (slot & 7) * 256, 36, 0, lam, lam_init, bid); }
        if (i >= 128) { const int slot = (i - 128) >> 3, bh = xcd * 2 + (slot >> 3); unit_C(p, lds, bh >> 2, bh & 3, (slot & 7) * 256, 36, 0); }
        if (i >= 128) {
#pragma unroll 1
            for (int hb = 0; hb < 2; ++hb) { const int slot = ((i - 128) >> 3) * 2 + hb; unit_B(p, l, lds, xcd >> 1, (xcd & 1) * 4 + (slot >> 3), (slot & 7) * 256, false); } }
        if (l == 0 && i < 64) { const int k = i;
            if (k < 16) unit_A(p, l, lds, k >> 2, k & 3, SEQ, 4, SEQ, lam, lam_init, bid);
            else if (k < 32) unit_C(p, lds, (k - 16) >> 2, (k - 16) & 3, SEQ, 4, SEQ);
            else unit_B(p, l, lds, (k - 32) >> 3, (k - 32) & 7, SEQ, true); }
    }
}

__device__ __forceinline__ void route_row(const Q& p, float logit  , int R, int lane, LAS int* lcnt) {
    const int e = lane >> 1;
    const float sg = 1.0f / (1.0f + expf(-logit));
    const float sel = sg + p.router_bias()[e];
    float v1 = sel; int i1 = e;
#pragma unroll
    for (int o = 2; o <= 8; o <<= 1) { const float ov = shx(v1, o); const int oi = bperm_i(i1, lane ^ o); const bool tk = (ov > v1) || (ov == v1 && oi < i1); v1 = tk ? ov : v1; i1 = tk ? oi : i1; }
    float v2 = (e == i1) ? -3e38f : sel; int i2 = (e == i1) ? 64 : e;
#pragma unroll
    for (int o = 2; o <= 8; o <<= 1) { const float ov = shx(v2, o); const int oi = bperm_i(i2, lane ^ o); const bool tk = (ov > v2) || (ov == v2 && oi < i2); v2 = tk ? ov : v2; i2 = tk ? oi : i2; }
    float gs = v1 + v2; int gb = e >> 3;
#pragma unroll
    for (int o = 16; o <= 32; o <<= 1) { const float ov = shx(gs, o); const int og = bperm_i(gb, lane ^ o); const bool tk = (ov > gs) || (ov == gs && og < gb); gs = tk ? ov : gs; gb = tk ? og : gb; }
    const int e0 = bperm_i(i1, gb * 16), e1 = bperm_i(i2, gb * 16);
    const float w0 = __int_as_float(bperm_i(__float_as_int(sg), e0 * 2)), w1 = __int_as_float(bperm_i(__float_as_int(sg), e1 * 2));
    if (lane == 0) {
        const float inv = 1.0f / (w0 + w1);
        p.tok_e()[R * 2] = e0; p.tok_e()[R * 2 + 1] = e1;
        p.tok_w()[R * 2] = w0 * inv; p.tok_w()[R * 2 + 1] = w1 * inv;
        p.tok_pos()[R * 2] = __hip_atomic_fetch_add(lcnt + e0, 1, __ATOMIC_RELAXED, __HIP_MEMORY_SCOPE_WORKGROUP);
        p.tok_pos()[R * 2 + 1] = __hip_atomic_fetch_add(lcnt + e1, 1, __ATOMIC_RELAXED, __HIP_MEMORY_SCOPE_WORKGROUP);
    }
}
__device__ __forceinline__ void ph_norm2(const Q& p, int l, LAS unsigned char* lds, int bid, int nb) {
    const int tid = lid(), lane = tid & 63, wid = __builtin_amdgcn_readfirstlane(tid >> 6), r32 = lane & 31, hh = lane >> 5;
    LAS float* red = (LAS float*)lds;
    LAS float* rstd_s = red + 8 * 32 * 32;
    LAS int* lcnt = (LAS int*)(rstd_s + 32);
    LAS float* m1s = rstd_s + 64;
    LAS float* shs = m1s + 2048;
    LAS float* xt = shs + 2048 + wid * (32 * 68);
    if (tid < 32) lcnt[tid] = 0;
    __syncthreads();
    const int nrows = l == 0 ? NR : NBATCH * SEQ, nsteps = nrows / 32;
    const float* g = p.norm2_g() + l * D_;
    att::bf16x8 bhi[16];
    {   const bf16_t* bh = p.rwT() + (size_t)r32 * 2048 + wid * 256 + hh * 8;
#pragma unroll
        for (int s_ = 0; s_ < 16; ++s_) bhi[s_] = *reinterpret_cast<const att::bf16x8*>(bh + s_ * 16); }
    for (int step = bid; step < nsteps; step += nb) {
        const int ri0 = step * 32, R0 = l == 0 ? ri0 : (ri0 >> 11) * TPB + (ri0 & 2047);
        const int b = R0 / TPB, t0 = R0 % TPB; const bool lat = t0 < SEQ;
        const float* xs = (lat ? (l == 0 ? p.x() : p.xw) + ((size_t)b * SEQ + t0) * D_ : (l == 0 ? p.ctx() : p.xc()) + ((size_t)b * CTXL + (t0 - SEQ)) * D_);
        const bf16_t* ds = p.dbuf() + (size_t)R0 * D_;
        const float* md = p.mod() + ((size_t)(l * 5 + (lat ? b : 4))) * 6 * D_;
        {   const int k = tid * 4; const f32x4v gv = *(const f32x4v*)(g + k), sc = *(const f32x4v*)(md + 4 * D_ + k), sh = *(const f32x4v*)(md + 3 * D_ + k);
            *(LAS f32x4v*)(m1s + k) = gv * (sc + 1.0f); *(LAS f32x4v*)(shs + k) = sh; }
        f32x4v xa[8], xb[8];
#pragma unroll
        for (int i = 0; i < 8; ++i) { const int k = (i * 64 + lane) * 4; xa[i] = *(const f32x4v*)(xs + (size_t)(wid * 4) * D_ + k); xb[i] = *(const f32x4v*)(xs + (size_t)(wid * 4 + 1) * D_ + k); }
        __builtin_amdgcn_sched_barrier(0);
#pragma unroll
        for (int hf = 0; hf < 2; ++hf) {
#pragma unroll
            for (int i = hf * 4; i < hf * 4 + 4; ++i) { const int k = (i * 64 + lane) * 4;
                xa[i] = xa[i] + bf4_to_f32(*(const uint2*)(ds + (size_t)(wid * 4) * D_ + k)); xb[i] = xb[i] + bf4_to_f32(*(const uint2*)(ds + (size_t)(wid * 4 + 1) * D_ + k)); }
            __builtin_amdgcn_sched_barrier(0); }
        __syncthreads();
#pragma unroll 1
        for (int rp = 0; rp < 2; ++rp) {
            const int ra = wid * 4 + rp * 2; float sa = 0.f, sb = 0.f;
#pragma unroll
            for (int i = 0; i < 8; ++i) { sa += xa[i][0] * xa[i][0] + xa[i][1] * xa[i][1] + xa[i][2] * xa[i][2] + xa[i][3] * xa[i][3];
                                          sb += xb[i][0] * xb[i][0] + xb[i][1] * xb[i][1] + xb[i][2] * xb[i][2] + xb[i][3] * xb[i][3]; }
            sa = wave_sum(sa); sb = wave_sum(sb);
            const float rsa = rsqrtf(sa / D_ + EPS), rsb = rsqrtf(sb / D_ + EPS);
            if (lane == 0) { rstd_s[ra] = rsa; rstd_s[ra + 1] = rsb; }
#pragma unroll
            for (int i = 0; i < 8; ++i) { const int k = (i * 64 + lane) * 4;
                const f32x4v m1 = *(const LAS f32x4v*)(m1s + k), sh = *(const LAS f32x4v*)(shs + k);
                const f32x4v ha = xa[i] * rsa * m1 + sh, hb = xb[i] * rsb * m1 + sh;
                uint2 w; w.x = pg8::cvt_pk_bf16(ha[0], ha[1]); w.y = pg8::cvt_pk_bf16(ha[2], ha[3]);
                *(uint2*)(p.hbuf() + (size_t)(R0 + ra) * D_ + k) = w;
                w.x = pg8::cvt_pk_bf16(hb[0], hb[1]); w.y = pg8::cvt_pk_bf16(hb[2], hb[3]);
                *(uint2*)(p.hbuf() + (size_t)(R0 + ra + 1) * D_ + k) = w; }
            if (rp == 0) {
#pragma unroll
                for (int i = 0; i < 8; ++i) { const int k = (i * 64 + lane) * 4; xa[i] = *(const f32x4v*)(xs + (size_t)(wid * 4 + 2) * D_ + k); xb[i] = *(const f32x4v*)(xs + (size_t)(wid * 4 + 3) * D_ + k); }
                __builtin_amdgcn_sched_barrier(0);
#pragma unroll
                for (int hf = 0; hf < 2; ++hf) {
#pragma unroll
                    for (int i = hf * 4; i < hf * 4 + 4; ++i) { const int k = (i * 64 + lane) * 4;
                        xa[i] = xa[i] + bf4_to_f32(*(const uint2*)(ds + (size_t)(wid * 4 + 2) * D_ + k)); xb[i] = xb[i] + bf4_to_f32(*(const uint2*)(ds + (size_t)(wid * 4 + 3) * D_ + k)); }
                    __builtin_amdgcn_sched_barrier(0); } }
        }
        __syncthreads();
        {   const float rs = rstd_s[r32];
            att::f32x16 acc = att::f32x16{};
            const LAS float* m1k = m1s + wid * 256 + hh * 8; const LAS float* shk = shs + wid * 256 + hh * 8;
#pragma unroll
            for (int sc4 = 0; sc4 < 4; ++sc4) {
                f32x4v xl[8];
#pragma unroll
                for (int i = 0; i < 8; ++i) { const size_t o_ = (size_t)(i * 4 + (lane >> 4)) * D_ + wid * 256 + sc4 * 64 + (lane & 15) * 4; xl[i] = *(const f32x4v*)(xs + o_) + bf4_to_f32(*(const uint2*)(ds + o_)); }
#pragma unroll
                for (int i = 0; i < 8; ++i) *(LAS f32x4v*)(xt + (i * 4 + (lane >> 4)) * 68 + (lane & 15) * 4) = xl[i];
                asm volatile("s_waitcnt lgkmcnt(0)" ::: "memory");
#pragma unroll
                for (int s4 = 0; s4 < 4; ++s4) { const int s_ = sc4 * 4 + s4;
                    const f32x4v x0 = *(const LAS f32x4v*)(xt + r32 * 68 + s4 * 16 + hh * 8), x1 = *(const LAS f32x4v*)(xt + r32 * 68 + s4 * 16 + hh * 8 + 4);
                    const f32x4v ma = *(const LAS f32x4v*)(m1k + s_ * 16), mb = *(const LAS f32x4v*)(m1k + s_ * 16 + 4), sa4 = *(const LAS f32x4v*)(shk + s_ * 16), sb4 = *(const LAS f32x4v*)(shk + s_ * 16 + 4);
                    const f32x4v h0 = x0 * rs * ma + sa4, h1 = x1 * rs * mb + sb4;
                    const float hv[8] = {h0[0], h0[1], h0[2], h0[3], h1[0], h1[1], h1[2], h1[3]};
                    float lo[8]; unsigned hp[4], lp[4];
#pragma unroll
                    for (int j = 0; j < 4; ++j) { hp[j] = pg8::cvt_pk_bf16(hv[2 * j], hv[2 * j + 1]);
                        lo[2 * j] = hv[2 * j] - __uint_as_float(hp[j] << 16); lo[2 * j + 1] = hv[2 * j + 1] - __uint_as_float(hp[j] & 0xffff0000u); }
#pragma unroll
                    for (int j = 0; j < 4; ++j) lp[j] = pg8::cvt_pk_bf16(lo[2 * j], lo[2 * j + 1]);
                    att::u32x4 hw = {hp[0], hp[1], hp[2], hp[3]}, lw = {lp[0], lp[1], lp[2], lp[3]};
                    const att::bf16x8 ahi = *reinterpret_cast<att::bf16x8*>(&hw), alo = *reinterpret_cast<att::bf16x8*>(&lw);
                    acc = __builtin_amdgcn_mfma_f32_32x32x16_bf16(ahi, bhi[s_], acc, 0, 0, 0);
                    acc = __builtin_amdgcn_mfma_f32_32x32x16_bf16(alo, bhi[s_], acc, 0, 0, 0); }
                asm volatile("s_waitcnt lgkmcnt(0)" ::: "memory");
            }
#pragma unroll
            for (int r = 0; r < 16; ++r) red[(wid * 32 + att::crow(r, hh)) * 32 + r32] = acc[r];
        }
        __syncthreads();
#pragma unroll 1
        for (int rr = 0; rr < 4; ++rr) { const int row = wid * 4 + rr; float lg = 0.f;
#pragma unroll
            for (int w = 0; w < 8; ++w) lg += red[(w * 32 + row) * 32 + (lane >> 1)];
            route_row(p, lg, R0 + row, lane, lcnt); }
        __syncthreads();
    }
    __syncthreads();
    if (tid < 32) p.wgcnt()[(l * 256 + bid) * 32 + tid] = lcnt[tid];
}

__device__ __forceinline__ int wg_of_row(int R, int l, int nb) { const int ri = l == 0 ? R : (R / TPB) * SEQ + R % TPB; return (ri >> 5) % nb; }
__device__ __forceinline__ void ph_permute(const Q& p, int l, LAS unsigned char* lds, int bid, int nb) {
    const int tid = lid(), lane = tid & 63, gw = __builtin_amdgcn_readfirstlane(bid * 8 + (tid >> 6)), nw = nb * 8;
    LAS int* base = (LAS int*)lds;
    LAS int* segs = base + 256 * 32;
    LAS int* soff = segs + 16 * 32;
    __syncthreads();
    { const int e = tid & 31, seg = tid >> 5; const int* wc = p.wgcnt() + (size_t)l * 256 * 32; int s_ = 0;
      for (int w = seg * 16; w < seg * 16 + 16; ++w) { const int v = w < nb ? wc[w * 32 + e] : 0; base[w * 32 + e] = s_; s_ += v; }
      segs[seg * 32 + e] = s_; }
    __syncthreads();
    if (tid < 32) { int run = 0; for (int sg = 0; sg < 16; ++sg) { const int t_ = segs[sg * 32 + tid]; segs[sg * 32 + tid] = run; run += t_; } soff[32 + tid] = run; }
    __syncthreads();
    { const int e = tid & 31, seg = tid >> 5; const int add = segs[seg * 32 + e]; for (int w = seg * 16; w < seg * 16 + 16; ++w) base[w * 32 + e] += add; }
    if (tid == 0) { int o = 0; for (int e = 0; e < 32; ++e) { soff[e] = o; o += (soff[32 + e] + 255) & ~255; } }
    if (bid == 0 && tid < 32) p.cnt()[(l * 32 + tid) * CNT_STRIDE] = soff[32 + tid];
    __syncthreads();
    const int* tke = p.tok_e(); int* tkp = p.tok_pos(); const bf16_t* hb = p.hbuf(); bf16_t* ab = p.Abuf();
    auto active = [&](int R) { return R < NR && !(l == 1 && (R % TPB) >= SEQ); };
    int R = gw; bool hv = active(R);
    uint4 c0 = make_uint4(0u, 0u, 0u, 0u), c1 = c0, c2 = c0, c3 = c0; int ce0 = 0, ce1 = 0, cp0 = 0, cp1 = 0;
    if (hv) { const uint4* src = (const uint4*)(hb + (size_t)R * D_); c0 = src[lane]; c1 = src[64 + lane]; c2 = src[128 + lane]; c3 = src[192 + lane];
        ce0 = tke[R * 2]; ce1 = tke[R * 2 + 1]; cp0 = tkp[R * 2]; cp1 = tkp[R * 2 + 1]; }
    for (; R < NR; R += nw) {
        const int Rn = R + nw; const bool hn = active(Rn);
        uint4 n0 = c0, n1 = c1, n2 = c2, n3 = c3; int ne0 = 0, ne1 = 0, np0 = 0, np1 = 0;
        if (hn) { const uint4* src = (const uint4*)(hb + (size_t)Rn * D_); n0 = src[lane]; n1 = src[64 + lane]; n2 = src[128 + lane]; n3 = src[192 + lane];
            ne0 = tke[Rn * 2]; ne1 = tke[Rn * 2 + 1]; np0 = tkp[Rn * 2]; np1 = tkp[Rn * 2 + 1]; }
        if (hv) {
            const int w = wg_of_row(R, l, nb);
            const int g0 = base[w * 32 + ce0] + cp0, g1 = base[w * 32 + ce1] + cp1;
            if (lane == 0) { tkp[R * 2] = g0; tkp[R * 2 + 1] = g1; }
            const int s0 = soff[ce0] + g0, s1 = soff[ce1] + g1;
            uint4* d0 = (uint4*)(ab + (size_t)s0 * D_); uint4* d1 = (uint4*)(ab + (size_t)s1 * D_);
            d0[lane] = c0; d0[64 + lane] = c1; d0[128 + lane] = c2; d0[192 + lane] = c3;
            d1[lane] = c0; d1[64 + lane] = c1; d1[128 + lane] = c2; d1[192 + lane] = c3;
        }
        c0 = n0; c1 = n1; c2 = n2; c3 = n3; ce0 = ne0; ce1 = ne1; cp0 = np0; cp1 = np1; hv = hn;
    }
}
__device__ __forceinline__ void moe_table(const Q& p, int l, LAS int* tab) {
    const int tid = lid(), lane = tid & 63;
    __syncthreads();
    if (tid < 64) {
        int total; const int offs = slot_offsets(p.cnt() + l * 32 * CNT_STRIDE, lane, total);
        const int nxt = bperm_i(offs, lane + 1);
        const int hi_ = lane < 31 ? nxt : total;
        if (lane < 32) for (int tl = offs >> 8; tl < (hi_ >> 8); ++tl) tab[8 + tl] = lane;
        if (lane == 0) tab[0] = total >> 8;
    }
    __syncthreads();
}

__global__ void __launch_bounds__(512, 2) mega(P p, int ph_lo, int ph_hi) {
    extern __shared__ __attribute__((aligned(16))) unsigned char shm_raw[];
    LAS unsigned char* lds = (LAS unsigned char*)shm_raw;
    const int bid0 = blockIdx.x, nb0 = gridDim.x, tid = threadIdx.x;
    if (tid < 4) ((LAS unsigned*)(lds + LDS_BAR_OFF))[tid] = 0u;
    __syncthreads();
    XcdBarrier bar; bar.bar = p.bar(); bar.x = 0; bar.st = (volatile LAS unsigned*)(lds + LDS_BAR_OFF);
    if (ph_hi - ph_lo > 1) bar = xcd_barrier_post(p.bar(), (volatile LAS unsigned*)(lds + LDS_BAR_OFF));
    LAS int* tab = (LAS int*)(lds + LDS_TAB_OFF);
#define PHASE_BEGIN(id) if ((id) >= ph_lo && (id) < ph_hi) { const int bid = sid(bid0), nb = sid(nb0); Q q; q.xw = sidp(p.xw); q.ws = sidp(p.ws);
#define PHASE_END(id) if ((id) + 1 < ph_hi) { XcdBarrier b2 = bar; b2.x = (unsigned)sid((int)b2.x); xcd_barrier(b2); } }
    PHASE_BEGIN(0) ph_prologue(p, lds, bid, nb);
        if (bid == 0 && tid == 0) { const float** tb = (const float**)(p.ws + WSO_tbl);
            tb[0] = p.x; tb[1] = p.c; tb[2] = p.ctx; tb[3] = p.c_ctx; tb[4] = p.ada_w; tb[5] = p.ada_b; tb[6] = p.norm1_g; tb[7] = p.norm2_g; tb[8] = p.w_in; tb[9] = p.w_out; tb[10] = p.a_qn; tb[11] = p.a_kn; tb[12] = p.a_lambda; tb[13] = p.a_subln; tb[14] = p.b_qn; tb[15] = p.b_kn; tb[16] = p.b_sink; tb[17] = p.c_qa_norm; tb[18] = p.c_kva_norm; tb[19] = p.c_wuq; tb[20] = p.c_wukv; tb[21] = p.c_qn; tb[22] = p.c_kn; tb[23] = p.router_w; tb[24] = p.router_bias; tb[25] = p.moe_w_gate; tb[26] = p.moe_w_up; tb[27] = p.moe_w_down; }
    PHASE_END(0)
    auto layer = [&](const int l) __attribute__((always_inline)) {
        const int pb = 1 + l * 11;
        PHASE_BEGIN(pb + 0) ph_rows_norm1(q, l == 0 ? -1 : 0, l, q.x(), q.ctx(), bid, nb); PHASE_END(pb + 0)
        PHASE_BEGIN(pb + 1) if (bid < NW_IN) { pg8::Gemm g{q.hbuf(), q.winT() + (size_t)l * ZLD * D_, NR, ZLD, D_}; pg8::StaticOrder S; S.init(NR, ZLD, NW_IN, bid);
            EpiStore E{q.z(), ZLD, 0x7fffffff}; pg8::gemm_phase<EpiStore, pg8::StaticOrder>(lds, g, S, E, nullptr); worker_done(q, pb + 1); }
            else bg_window(q, lds, pb + 1, NW_IN, l); PHASE_END(pb + 1)
        PHASE_BEGIN(pb + 2) ph_post1(q, l, bid, nb); PHASE_END(pb + 2)
        PHASE_BEGIN(pb + 3) {
            if (bid < 108) { pg8::Gemm g{q.cqn(), q.wuqT() + (size_t)l * 768 * 512, NR, 768, 512}; pg8::StaticOrder S; S.init(NR, 768, 108, bid);
                EpiStore E{q.q2(), 768, 0x7fffffff}; pg8::gemm_phase<EpiStore, pg8::StaticOrder>(lds, g, S, E, nullptr); }
            else if (bid < 252) { pg8::Gemm g{q.ckvn(), q.wukvT() + (size_t)l * 1024 * 256, NR, 1024, 256}; pg8::StaticOrder S; S.init(NR, 1024, 144, bid - 108);
                EpiStore E{q.kv2(), 1024, 0x7fffffff}; pg8::gemm_phase<EpiStore, pg8::StaticOrder>(lds, g, S, E, nullptr); }
        } PHASE_END(pb + 3)
        PHASE_BEGIN(pb + 4) ph_post2(q, l, bid, nb); PHASE_END(pb + 4)
        PHASE_BEGIN(pb + 5) ph_attn(q, l, lds, bid, nb); PHASE_END(pb + 5)
        PHASE_BEGIN(pb + 6) { const bool win = (l == 0);
            if (!win || bid < NW_OUT) { pg8::Gemm g{q.mix(), q.woutT() + (size_t)l * D_ * D_, NR, D_, D_}; MapOrder S; S.init(l == 0 ? NR : NBATCH * SEQ, D_, win ? NW_OUT : nb, bid); S.skipctx = l;
                EpiOutProj E{q.dbuf(), q.mod() + (size_t)l * 5 * 6 * D_};
                pg8::gemm_phase<EpiOutProj, MapOrder>(lds, g, S, E, nullptr); if (win) worker_done(q, pb + 6); }
            else bg_window(q, lds, pb + 6, NW_OUT, 0); } PHASE_END(pb + 6)
        PHASE_BEGIN(pb + 7) ph_norm2(q, l, lds, bid, nb); PHASE_END(pb + 7)
        PHASE_BEGIN(pb + 8) bg_drain(q, lds, l, bid, nb); ph_permute(q, l, lds, bid, nb); PHASE_END(pb + 8)
        PHASE_BEGIN(pb + 9) { const bool win = (l == 0);
            if (!win || bid < NW_GU) { moe_table(q, l, tab);
                pg8::Gemm g{q.Abuf(), q.guT() + (size_t)l * NEXP * 1024 * D_, MAXSLOT, NEXP * 1024, D_}; MoeOrder S{tab, 4, win ? NW_GU : nb, bid};
                EpiGateUp E{q.actbuf()}; pg8::gemm_phase<EpiGateUp, MoeOrder>(lds, g, S, E, nullptr); if (win) worker_done(q, pb + 9); }
            else bg_window(q, lds, pb + 9, NW_GU, 1); } PHASE_END(pb + 9)
        PHASE_BEGIN(pb + 10) { moe_table(q, l, tab);
            pg8::Gemm g{q.actbuf(), q.dT() + (size_t)l * NEXP * D_ * DEXP, MAXSLOT, NEXP * D_, DEXP}; MoeOrder S{tab, 8, nb, bid};
            EpiStore E{q.yslot(), D_, 7}; pg8::gemm_phase<EpiStore, MoeOrder>(lds, g, S, E, nullptr); } PHASE_END(pb + 10)
    };
    layer(0);
    layer(1);
    PHASE_BEGIN(23) ph_rows_norm1(q, 1, -1, q.xw, q.xc(), bid, nb); PHASE_END(23)
#undef PHASE_BEGIN
#undef PHASE_END
}

static inline size_t al256(size_t v) { return (v + 255) & ~(size_t)255; }

extern "C" void kernel_launch(void* const* d_in, const int* in_sizes, int n_in, void* d_out, int out_size, void* d_ws, size_t ws_size, hipStream_t stream) {
    (void)in_sizes; (void)n_in; (void)out_size;
    P p{};
    const float* const* in = (const float* const*)d_in;
    p.x = in[0]; p.c = in[1]; p.ctx = in[2]; p.c_ctx = in[3]; p.ada_w = in[4]; p.ada_b = in[5]; p.norm1_g = in[6]; p.norm2_g = in[7]; p.w_in = in[8]; p.w_out = in[9];
    p.a_qn = in[10]; p.a_kn = in[11]; p.a_lambda = in[12]; p.a_subln = in[13]; p.b_qn = in[14]; p.b_kn = in[15]; p.b_sink = in[16];
    p.c_qa_norm = in[17]; p.c_kva_norm = in[18]; p.c_wuq = in[19]; p.c_wukv = in[20]; p.c_qn = in[21]; p.c_kn = in[22];
    p.router_w = in[23]; p.router_bias = in[24]; p.moe_w_gate = in[25]; p.moe_w_up = in[26]; p.moe_w_down = in[27];
    p.xw = (float*)d_out; p.ws = (char*)d_ws;
    const size_t o = WS_END2, ctl_bytes = CTL_BYTES;
    static_assert(XCD_BAR_WORDS == 3456, "workspace map assumes 3456 barrier words");
    static int grid = 0;
    if (!grid) {
        if (o > ws_size) { fprintf(stderr, "kernel_launch: workspace too small: need %zu have %zu\n", o, ws_size); grid = -1; return; }
        int dev = 0, cus = 0, per_cu = 0;
        if (hipGetDevice(&dev) != hipSuccess || hipDeviceGetAttribute(&cus, hipDeviceAttributeMultiprocessorCount, dev) != hipSuccess) { grid = -1; return; }
        if (hipFuncSetAttribute((const void*)mega, hipFuncAttributeMaxDynamicSharedMemorySize, LDS_TOTAL) != hipSuccess) { fprintf(stderr, "kernel_launch: hipFuncSetAttribute failed\n"); grid = -1; return; }
        if (hipOccupancyMaxActiveBlocksPerMultiprocessor(&per_cu, (const void*)mega, 512, LDS_TOTAL) != hipSuccess || per_cu < 1) { fprintf(stderr, "kernel_launch: occupancy query says %d\n", per_cu); grid = -1; return; }
        if (cus < 256) { fprintf(stderr, "kernel_launch: built for a 256-CU device (MI355X), found %d CUs; nothing launched\n", cus); grid = -1; return; }
        grid = 256;
    }
    if (grid < 0) return;
    (void)hipMemsetAsync(p.bar(), 0, ctl_bytes, stream);
    hipLaunchKernelGGL(mega, dim3(grid), dim3(512), LDS_TOTAL, stream, p, 0, NPHASE);
}
```

```cpp
#include <hip/hip_runtime.h>
#include <stdint.h>
#include <cstdio>

typedef unsigned short bf16_t;

#define D_ 2048
#define NBATCH 4
#define SEQ 2048
#define CTXL 256
#define TPB 2304
#define NR 9216
#define DIN 3904
#define ZLD 4096
#define NEXP 32
#define DEXP 512
#define MAXSLOT 26624
#define EPS 1e-6f
#define LOG2E 1.4426950408889634f

__device__ __forceinline__ float bf2f(bf16_t v) { return __uint_as_float(((unsigned)v) << 16); }
__device__ __forceinline__ bf16_t f2bf(float f) { unsigned u = __float_as_uint(f); u += 0x7FFFu + ((u >> 16) & 1u); return (bf16_t)(u >> 16); }

constexpr size_t ws_al(size_t v) { return (v + 255) & ~(size_t)255; }
constexpr size_t WSO_bar = 0;
constexpr size_t CTL_BYTES = (size_t)3456 * 4 + 256 + 256 + 32 * 256 + 64 * 256;
#define CNT_STRIDE 64
constexpr size_t WSO_slot_off = WSO_bar + ws_al(CTL_BYTES);
constexpr size_t WSO_xc = WSO_slot_off + ws_al(2 * 33 * 4);
constexpr size_t WSO_mod = WSO_xc + ws_al((size_t)NBATCH * CTXL * D_ * 4);
constexpr size_t WSO_cosA = WSO_mod + ws_al((size_t)2 * 5 * 6 * D_ * 4);
constexpr size_t WSO_sinA = WSO_cosA + ws_al(2048 * 32 * 4);
constexpr size_t WSO_cosB = WSO_sinA + ws_al(2048 * 32 * 4);
constexpr size_t WSO_sinB = WSO_cosB + ws_al(2048 * 64 * 4);
constexpr size_t WSO_winT = WSO_sinB + ws_al(2048 * 64 * 4);
constexpr size_t WSO_woutT = WSO_winT + ws_al((size_t)2 * ZLD * D_ * 2);
constexpr size_t WSO_wuqT = WSO_woutT + ws_al((size_t)2 * D_ * D_ * 2);
constexpr size_t WSO_wukvT = WSO_wuqT + ws_al((size_t)2 * 768 * 512 * 2);
constexpr size_t WSO_guT = WSO_wukvT + ws_al((size_t)2 * 1024 * 256 * 2);
constexpr size_t WSO_dT = WSO_guT + ws_al((size_t)2 * NEXP * 1024 * D_ * 2);
constexpr size_t WSO_hbuf = WSO_dT + ws_al((size_t)2 * NEXP * D_ * DEXP * 2);
constexpr size_t WSO_z = WSO_hbuf + ws_al((size_t)NR * D_ * 2);
constexpr size_t WSO_QA = WSO_z + ws_al((size_t)NR * ZLD * 2);
constexpr size_t WSO_KA = WSO_QA + ws_al((size_t)NR * 512 * 2);
constexpr size_t WSO_QB = WSO_KA + ws_al((size_t)NR * 512 * 2);
constexpr size_t WSO_KB = WSO_QB + ws_al((size_t)NR * 1024 * 2);
constexpr size_t WSO_cqn = WSO_KB + ws_al((size_t)NR * 256 * 2);
constexpr size_t WSO_ckvn = WSO_cqn + ws_al((size_t)NR * 512 * 2);
constexpr size_t WSO_krope = WSO_ckvn + ws_al((size_t)NR * 256 * 2);
constexpr size_t WSO_q2 = WSO_krope + ws_al((size_t)NR * 64 * 2);
constexpr size_t WSO_kv2 = WSO_q2 + ws_al((size_t)NR * 768 * 2);
constexpr size_t WSO_QC = WSO_kv2 + ws_al((size_t)NR * 1024 * 2);
constexpr size_t WSO_KC = WSO_QC + ws_al((size_t)NR * 768 * 2);
constexpr size_t WSO_mix = WSO_KC + ws_al((size_t)NR * 768 * 2);
constexpr size_t WSO_oscr = WSO_mix + ws_al((size_t)NR * D_ * 2);
constexpr size_t WSO_tok_e = WSO_oscr + ws_al((size_t)256 * 256 * 128 * 4);
constexpr size_t WSO_tok_pos = WSO_tok_e + ws_al((size_t)NR * 2 * 4);
constexpr size_t WSO_tok_w = WSO_tok_pos + ws_al((size_t)NR * 2 * 4);
constexpr size_t WSO_Abuf = WSO_tok_w + ws_al((size_t)NR * 2 * 4);
constexpr size_t WSO_actbuf = WSO_Abuf + ws_al((size_t)MAXSLOT * D_ * 2);
constexpr size_t WS_END = WSO_actbuf + ws_al((size_t)MAXSLOT * DEXP * 2);
constexpr size_t WSO_tbl = WS_END;
constexpr size_t WSO_wgcnt = WS_END + 256;
constexpr size_t WSO_rwT = WSO_wgcnt + 2 * 256 * 32 * 4;
constexpr size_t WSO_dbuf = WSO_rwT + 2 * 32 * 2048 * 2;
constexpr size_t WSO_stok = WSO_dbuf + (size_t)NR * D_ * 2;
constexpr size_t WSO_smap = WSO_stok + (size_t)MAXSLOT * 4;
constexpr size_t WSO_x1b = WSO_smap + (size_t)NEXP * NR * 4;
constexpr size_t WS_END2 = WSO_x1b + (size_t)NBATCH * SEQ * D_ * 2;
struct WsMap {
    float *xw;
    char *ws;
    __host__ __device__ __forceinline__ unsigned* bar() const { return (unsigned*)(ws + WSO_bar); }
    __host__ __device__ __forceinline__ int* slot_off() const { return (int*)(ws + WSO_slot_off); }
    __host__ __device__ __forceinline__ float* xc() const { return (float*)(ws + WSO_xc); }
    __host__ __device__ __forceinline__ float* mod() const { return (float*)(ws + WSO_mod); }
    __host__ __device__ __forceinline__ float* cosA() const { return (float*)(ws + WSO_cosA); }
    __host__ __device__ __forceinline__ float* sinA() const { return (float*)(ws + WSO_sinA); }
    __host__ __device__ __forceinline__ float* cosB() const { return (float*)(ws + WSO_cosB); }
    __host__ __device__ __forceinline__ float* sinB() const { return (float*)(ws + WSO_sinB); }
    __host__ __device__ __forceinline__ bf16_t* winT() const { return (bf16_t*)(ws + WSO_winT); }
    __host__ __device__ __forceinline__ bf16_t* woutT() const { return (bf16_t*)(ws + WSO_woutT); }
    __host__ __device__ __forceinline__ bf16_t* wuqT() const { return (bf16_t*)(ws + WSO_wuqT); }
    __host__ __device__ __forceinline__ bf16_t* wukvT() const { return (bf16_t*)(ws + WSO_wukvT); }
    __host__ __device__ __forceinline__ bf16_t* guT() const { return (bf16_t*)(ws + WSO_guT); }
    __host__ __device__ __forceinline__ bf16_t* dT() const { return (bf16_t*)(ws + WSO_dT); }
    __host__ __device__ __forceinline__ bf16_t* hbuf() const { return (bf16_t*)(ws + WSO_hbuf); }
    __host__ __device__ __forceinline__ bf16_t* z() const { return (bf16_t*)(ws + WSO_z); }
    __host__ __device__ __forceinline__ bf16_t* QA() const { return (bf16_t*)(ws + WSO_QA); }
    __host__ __device__ __forceinline__ bf16_t* KA() const { return (bf16_t*)(ws + WSO_KA); }
    __host__ __device__ __forceinline__ bf16_t* QB() const { return (bf16_t*)(ws + WSO_QB); }
    __host__ __device__ __forceinline__ bf16_t* KB() const { return (bf16_t*)(ws + WSO_KB); }
    __host__ __device__ __forceinline__ bf16_t* cqn() const { return (bf16_t*)(ws + WSO_cqn); }
    __host__ __device__ __forceinline__ bf16_t* ckvn() const { return (bf16_t*)(ws + WSO_ckvn); }
    __host__ __device__ __forceinline__ bf16_t* krope() const { return (bf16_t*)(ws + WSO_krope); }
    __host__ __device__ __forceinline__ bf16_t* q2() const { return (bf16_t*)(ws + WSO_q2); }
    __host__ __device__ __forceinline__ bf16_t* kv2() const { return (bf16_t*)(ws + WSO_kv2); }
    __host__ __device__ __forceinline__ bf16_t* QC() const { return (bf16_t*)(ws + WSO_QC); }
    __host__ __device__ __forceinline__ bf16_t* KC() const { return (bf16_t*)(ws + WSO_KC); }
    __host__ __device__ __forceinline__ bf16_t* mix() const { return (bf16_t*)(ws + WSO_mix); }
    __host__ __device__ __forceinline__ float* oscr() const { return (float*)(ws + WSO_oscr); }
    __host__ __device__ __forceinline__ int* tok_e() const { return (int*)(ws + WSO_tok_e); }
    __host__ __device__ __forceinline__ int* tok_pos() const { return (int*)(ws + WSO_tok_pos); }
    __host__ __device__ __forceinline__ float* tok_w() const { return (float*)(ws + WSO_tok_w); }
    __host__ __device__ __forceinline__ bf16_t* Abuf() const { return (bf16_t*)(ws + WSO_Abuf); }
    __host__ __device__ __forceinline__ bf16_t* actbuf() const { return (bf16_t*)(ws + WSO_actbuf); }
    __host__ __device__ __forceinline__ int* cnt() const { return (int*)(ws + WSO_bar + (size_t)3456 * 4 + 512 + 32 * 256); }
    __host__ __device__ __forceinline__ bf16_t* dbuf() const { return (bf16_t*)(ws + WSO_dbuf); }
    __host__ __device__ __forceinline__ bf16_t* rwT() const { return (bf16_t*)(ws + WSO_rwT); }
    __host__ __device__ __forceinline__ int* wgcnt() const { return (int*)(ws + WSO_wgcnt); }
    __host__ __device__ __forceinline__ int* qhead() const { return (int*)(ws + WSO_bar + (size_t)3456 * 4 + 256); }
    __host__ __device__ __forceinline__ int* pdone(int ph) const { return (int*)(ws + WSO_bar + (size_t)3456 * 4 + 512 + (size_t)ph * 256); }
    __host__ __device__ __forceinline__ int* slot_tok() const { return (int*)(ws + WSO_stok); }
    __host__ __device__ __forceinline__ int* smap() const { return (int*)(ws + WSO_smap); }
    __host__ __device__ __forceinline__ bf16_t* x1b() const { return (bf16_t*)(ws + WSO_x1b); }
    __host__ __device__ __forceinline__ bf16_t* yslot() const { return Abuf(); }
};
struct P : WsMap {
    static constexpr bool HAS_FIELDS = true;
    const float *x, *c, *ctx, *c_ctx, *ada_w, *ada_b, *norm1_g, *norm2_g, *w_in, *w_out;
    const float *a_qn, *a_kn, *a_lambda, *a_subln, *b_qn, *b_kn, *b_sink;
    const float *c_qa_norm, *c_kva_norm, *c_wuq, *c_wukv, *c_qn, *c_kn;
    const float *router_w, *router_bias, *moe_w_gate, *moe_w_up, *moe_w_down;
};
struct Q : WsMap {
    static constexpr bool HAS_FIELDS = false;
    __device__ __forceinline__ const float* tbl(int i) const { const unsigned long long v = ((const unsigned long long*)(ws + WSO_tbl))[i];
        return (const float*)(((unsigned long long)(unsigned)__builtin_amdgcn_readfirstlane((int)(v >> 32)) << 32) | (unsigned long long)(unsigned)__builtin_amdgcn_readfirstlane((int)(unsigned)v)); }
    __device__ __forceinline__ const float* x() const { return tbl(0); }
    __device__ __forceinline__ const float* c() const { return tbl(1); }
    __device__ __forceinline__ const float* ctx() const { return tbl(2); }
    __device__ __forceinline__ const float* c_ctx() const { return tbl(3); }
    __device__ __forceinline__ const float* ada_w() const { return tbl(4); }
    __device__ __forceinline__ const float* ada_b() const { return tbl(5); }
    __device__ __forceinline__ const float* norm1_g() const { return tbl(6); }
    __device__ __forceinline__ const float* norm2_g() const { return tbl(7); }
    __device__ __forceinline__ const float* w_in() const { return tbl(8); }
    __device__ __forceinline__ const float* w_out() const { return tbl(9); }
    __device__ __forceinline__ const float* a_qn() const { return tbl(10); }
    __device__ __forceinline__ const float* a_kn() const { return tbl(11); }
    __device__ __forceinline__ const float* a_lambda() const { return tbl(12); }
    __device__ __forceinline__ const float* a_subln() const { return tbl(13); }
    __device__ __forceinline__ const float* b_qn() const { return tbl(14); }
    __device__ __forceinline__ const float* b_kn() const { return tbl(15); }
    __device__ __forceinline__ const float* b_sink() const { return tbl(16); }
    __device__ __forceinline__ const float* c_qa_norm() const { return tbl(17); }
    __device__ __forceinline__ const float* c_kva_norm() const { return tbl(18); }
    __device__ __forceinline__ const float* c_wuq() const { return tbl(19); }
    __device__ __forceinline__ const float* c_wukv() const { return tbl(20); }
    __device__ __forceinline__ const float* c_qn() const { return tbl(21); }
    __device__ __forceinline__ const float* c_kn() const { return tbl(22); }
    __device__ __forceinline__ const float* router_w() const { return tbl(23); }
    __device__ __forceinline__ const float* router_bias() const { return tbl(24); }
    __device__ __forceinline__ const float* moe_w_gate() const { return tbl(25); }
    __device__ __forceinline__ const float* moe_w_up() const { return tbl(26); }
    __device__ __forceinline__ const float* moe_w_down() const { return tbl(27); }
};


__device__ __forceinline__ int lid() { int t = threadIdx.x; asm volatile("" : "+v"(t)); return t; }
__device__ __forceinline__ int sid(int v) { asm volatile("" : "+s"(v)); return v; }
__device__ __forceinline__ char* sidp(char* v) { asm volatile("" : "+s"(v)); return v; }
__device__ __forceinline__ float* sidp(float* v) { asm volatile("" : "+s"(v)); return v; }
__device__ __forceinline__ float shx(float v, int m) { return __int_as_float(__builtin_amdgcn_ds_bpermute(((lid() ^ m) & 63) << 2, __float_as_int(v))); }
__device__ __forceinline__ int bperm_i(int v, int src_lane) { return __builtin_amdgcn_ds_bpermute((src_lane & 63) << 2, v); }
__device__ __forceinline__ float wave_sum(float v) {
#pragma unroll
    for (int o = 32; o >= 1; o >>= 1) v += shx(v, o);
    return v;
}
template <int W> __device__ __forceinline__ float grp_sum(float v) {
#pragma unroll
    for (int o = W / 2; o >= 1; o >>= 1) v += shx(v, o);
    return v;
}
#define XB_TMO      128
#define XB_XCNT(j)  (256  + 64 * (j))
#define XB_XSUB(j)  (1280 + 64 * (j))
#define XB_XGEN(j)  (2304 + 64 * (j))
#define XB_TOP      3328
#define XB_TOPGEN   3392
#define XCD_BAR_WORDS 3456
#define XB_SPIN_CAP (1u << 18)
#define LAS __attribute__((address_space(3)))

__device__ __forceinline__ unsigned xb_ld(unsigned* p)              { return __hip_atomic_load(p, __ATOMIC_RELAXED, __HIP_MEMORY_SCOPE_AGENT); }
__device__ __forceinline__ unsigned xb_add(unsigned* p, unsigned v) { return __hip_atomic_fetch_add(p, v, __ATOMIC_RELAXED, __HIP_MEMORY_SCOPE_AGENT); }
__device__ __forceinline__ unsigned xb_xcc_id() { return (unsigned)__builtin_amdgcn_s_getreg((3 << 11) | 20) & 0xFu; }
#define XB_SPIN(cond, bar) do { unsigned _sp = 0; while (cond) { __builtin_amdgcn_s_sleep(1); \
    if ((++_sp & 255u) == 0u) { if (xb_ld(&(bar)[XB_TMO])) break; if (_sp > XB_SPIN_CAP) { atomicAdd(&(bar)[XB_TMO], 1u); break; } } } } while (0)

struct XcdBarrier {
    unsigned* bar; unsigned x;
    volatile LAS unsigned* st;
};

__device__ __forceinline__ XcdBarrier xcd_barrier_post(unsigned* bar, volatile LAS unsigned* st) {
    XcdBarrier b; b.bar = bar; b.x = xb_xcc_id(); b.st = st;
    if (threadIdx.x == 0) (void)xb_add(&bar[XB_XCNT(b.x)], 1u);
    return b;
}
__device__ __forceinline__ void xcd_barrier_complete(unsigned* bar, unsigned x, unsigned& nloc, unsigned& nx) {
    const unsigned G = gridDim.x * gridDim.y * gridDim.z;
    unsigned sum, cnt, mine, sp = 0u;
    for (;;) {
        sum = 0u; cnt = 0u; mine = 0u;
#pragma unroll
        for (unsigned j = 0; j < 16; ++j) { const unsigned c = xb_ld(&bar[XB_XCNT(j)]); sum += c; cnt += (c > 0u) ? 1u : 0u; mine = (j == x) ? c : mine; }
        if (sum == G) break;
        __builtin_amdgcn_s_sleep(1);
        if ((++sp & 255u) == 0u) { if (xb_ld(&bar[XB_TMO])) break; if (sp > XB_SPIN_CAP) { atomicAdd(&bar[XB_TMO], 1u); break; } }
    }
    nloc = mine > 0u ? mine : 1u; nx = cnt > 0u ? cnt : 1u;
}

__device__ __forceinline__ void xcd_barrier(const XcdBarrier& b) {
    asm volatile("s_waitcnt vmcnt(0)" ::: "memory");
    __syncthreads();
    if (threadIdx.x == 0) {
        unsigned* bar = b.bar;
        __builtin_amdgcn_s_waitcnt(0);
        unsigned nloc = b.st[0], nx = b.st[1];
        if (nloc == 0u) { xcd_barrier_complete(bar, b.x, nloc, nx); b.st[0] = nloc; b.st[1] = nx; }
        const unsigned old = xb_add(&bar[XB_XSUB(b.x)], 1u);
        const unsigned gen = old / nloc;
        if (old + 1u == (gen + 1u) * nloc) {
            __builtin_amdgcn_fence(__ATOMIC_RELEASE, "agent");
            asm volatile("s_waitcnt vmcnt(0)" ::: "memory");
            const unsigned og = xb_add(&bar[XB_TOP], 1u);
            const unsigned tg = og / nx;
            if (og + 1u == (tg + 1u) * nx) xb_add(&bar[XB_TOPGEN], 1u);
            else XB_SPIN(xb_ld(&bar[XB_TOPGEN]) == tg, bar);
            __builtin_amdgcn_fence(__ATOMIC_ACQUIRE, "agent");
            xb_add(&bar[XB_XGEN(b.x)], 1u);
            asm volatile("s_waitcnt vmcnt(0)" ::: "memory");
        } else {
            XB_SPIN(xb_ld(&bar[XB_XGEN(b.x)]) == gen, bar);
            __builtin_amdgcn_fence(__ATOMIC_ACQUIRE, "agent");
            asm volatile("s_waitcnt vmcnt(0)" ::: "memory");
        }
    }
    __syncthreads();
}
namespace pg8 {
#define PG8_LAS __attribute__((address_space(3)))
typedef unsigned short bf16_t;
typedef short bf16x8 __attribute__((ext_vector_type(8)));
typedef float f32x4 __attribute__((ext_vector_type(4)));
typedef unsigned u32x4 __attribute__((ext_vector_type(4)));
constexpr int BM = 256, BK = 64, HALF = 128, HTB = HALF * BK * 2  , STAGE_BYTES = 8 * HTB, NXCD = 8, WGM = 8;

__host__ __device__ __forceinline__ int lds_byte(int r, int c) { const int st = (r >> 4) * 2 + (c >> 5), rr = r & 15, cc = c & 31, ob = rr * 64 + cc * 2; return st * 1024 + (ob ^ (((ob >> 9) & 1) << 5)); }
__host__ __device__ __forceinline__ void stage_rc(int b, int& R, int& C) { const int st = b / 1024, sb = b % 1024, swz = sb ^ (((sb >> 9) & 1) << 5); R = (st >> 1) * 16 + swz / 64; C = (st & 1) * 32 + (swz % 64) / 2; }
__host__ __device__ __forceinline__ int perm32(int rho) { const int n = rho >> 4, i = rho & 15; return 8 * (i >> 2) + 4 * n + (i & 3); }

struct Unit { int pm, pn; };
struct Gemm { const bf16_t* A; const bf16_t* Bt; int M, N, K; };

struct StaticOrder {
    static constexpr bool GATHER = false;
    int nM, nN, nwg, G, c;
    __host__ __device__ void init(int M, int N, int G_, int c_) { nM = M / BM; nN = N / BM; nwg = nM * nN; G = G_; c = c_; }
    __host__ __device__ bool next(int i, Unit& u) const {
        const long L = (long)i * G + c; if (L >= nwg) return false;
        int wgid = (int)L; { const int q = nwg / NXCD, r = nwg % NXCD, xcd = wgid % NXCD, off = wgid / NXCD; wgid = (xcd < r ? xcd * (q + 1) : r * (q + 1) + (xcd - r) * q) + off; }
        const int nig = WGM * nN, gid = wgid / nig, fm = gid * WGM, gsz = (nM - fm) < WGM ? (nM - fm) : WGM;
        u.pm = fm + ((wgid % nig) % gsz); u.pn = (wgid % nig) / gsz; return true;
    }
    __device__ __forceinline__ void a_ready(const Unit&) const {}
    __device__ __forceinline__ void done(const Unit&) const {}
};
__device__ __forceinline__ unsigned cvt_pk_bf16(float lo, float hi) { unsigned r; asm volatile("v_cvt_pk_bf16_f32 %0, %1, %2" : "=v"(r) : "v"(lo), "v"(hi)); return r; }
template <class Epi, class Sched, bool STAMP = false>
__device__ __forceinline__ void gemm_phase(PG8_LAS unsigned char* lds, const Gemm g, const Sched& S, const Epi& E, unsigned long long* stamps) {
    const int tid = lid(), wid = __builtin_amdgcn_readfirstlane(tid >> 6), lane = tid & 63, wr = wid >> 2, wc = wid & 3, fr = lane & 15, fq = lane >> 4;
    const int K = g.K, nt = K / BK;
    int ts_lo = 0, ts_hi = 0, nts = 0; const unsigned long long rt_entry = STAMP ? (unsigned long long)wall_clock64() : 0ull;
#define PG8_STAMP() do { if (STAMP && wid == 0 && nts < 64) { const unsigned long long _c = (unsigned long long)clock64(); \
        ts_lo = (lane == nts) ? (int)(unsigned)_c : ts_lo; ts_hi = (lane == nts) ? (int)(unsigned)(_c >> 32) : ts_hi; ++nts; } } while (0)
    PG8_STAMP();
    unsigned voffA[2], voffB[2];
    int gR[2]; unsigned gC[2];
#pragma unroll
    for (int i = 0; i < 2; ++i) { int R, C; stage_rc(tid * 16 + i * 8192, R, C); const int Rb = Epi::PERM ? ((R & ~31) + perm32(R & 31)) : R;
        voffA[i] = (unsigned)(R * K + C) * 2u; voffB[i] = (unsigned)(Rb * K + C) * 2u; gR[i] = R; gC[i] = (unsigned)C * 2u; }
    unsigned vgc00 = 0, vgc01 = 0, vgc10 = 0, vgc11 = 0, vgn00 = 0, vgn01 = 0, vgn10 = 0, vgn11 = 0;
#define PG8_GATH(U, V) do { V##00 = (unsigned)S.row(U, gR[0]) * (unsigned)(K * 2) + gC[0]; V##01 = (unsigned)S.row(U, gR[1]) * (unsigned)(K * 2) + gC[1]; \
        V##10 = (unsigned)S.row(U, HALF + gR[0]) * (unsigned)(K * 2) + gC[0]; V##11 = (unsigned)S.row(U, HALF + gR[1]) * (unsigned)(K * 2) + gC[1]; } while (0)
#define PG8_STAGE2(bufoff, gbase, v0, v1) do { \
        __builtin_amdgcn_global_load_lds((const unsigned*)((const char*)(gbase) + (v0)), (PG8_LAS unsigned*)(lds + (bufoff) + ldsw), 16, 0, 0); \
        __builtin_amdgcn_global_load_lds((const unsigned*)((const char*)(gbase) + (v1)), (PG8_LAS unsigned*)(lds + (bufoff) + ldsw + 8192), 16, 0, 0); } while (0)
    const size_t kstep = (size_t)(BK * 2);
    const size_t hstep = (size_t)HALF * K * 2;
    const size_t tstep = 2 * hstep;
    const unsigned ldsw = (unsigned)wid * 1024u;
    const int aoff = lds_byte(wr * 64 + fr, fq * 8), boff = lds_byte(wc * 32 + fr, fq * 8);
#define PG8_SA(b, h) (((b) * 2 + (h)) * HTB)
#define PG8_SB(b, h) ((4 + (b) * 2 + (h)) * HTB)
#define PG8_STAGE(bufoff, gbase, voff) do { _Pragma("unroll") for (int _i = 0; _i < 2; ++_i) \
        __builtin_amdgcn_global_load_lds((const unsigned*)((const char*)(gbase) + (voff)[_i]), (PG8_LAS unsigned*)(lds + (bufoff) + ldsw + _i * 8192), 16, 0, 0); } while (0)
#define PG8_LDA(dst, b, h) do { _Pragma("unroll") for (int m = 0; m < 4; ++m) _Pragma("unroll") for (int k = 0; k < 2; ++k) dst[m][k] = *(const PG8_LAS bf16x8*)(lds + PG8_SA(b, h) + aoff + m * 2048 + k * 1024); } while (0)
#define PG8_LDB(dst, b, h) do { _Pragma("unroll") for (int n = 0; n < 2; ++n) _Pragma("unroll") for (int k = 0; k < 2; ++k) dst[n][k] = *(const PG8_LAS bf16x8*)(lds + PG8_SB(b, h) + boff + n * 2048 + k * 1024); } while (0)
#define PG8_MMA(ai, bj, At, Bt) do { __builtin_amdgcn_s_setprio(1); _Pragma("unroll") for (int m = 0; m < 4; ++m) _Pragma("unroll") for (int n = 0; n < 2; ++n) _Pragma("unroll") for (int k = 0; k < 2; ++k) \
        acc[ai][bj][m][n] = __builtin_amdgcn_mfma_f32_16x16x32_bf16(Bt[n][k], At[m][k], acc[ai][bj][m][n], 0, 0, 0); __builtin_amdgcn_s_setprio(0); } while (0)
#define PG8_WAIT_V(n) asm volatile("s_waitcnt vmcnt(" #n ")" ::: "memory")
#define PG8_WAIT_L(n) asm volatile("s_waitcnt lgkmcnt(" #n ")" ::: "memory")
#define PG8_BAR __builtin_amdgcn_s_barrier()
#define PG8_SCHED __builtin_amdgcn_sched_barrier(0)
    Unit cur, nxt; int ui = 0;
    if (!S.next(0, cur)) return;
    f32x4 acc[2][2][4][2];
#pragma unroll
    for (int a = 0; a < 2; ++a)
#pragma unroll
        for (int b = 0; b < 2; ++b)
#pragma unroll
            for (int m = 0; m < 4; ++m)
#pragma unroll
                for (int n = 0; n < 2; ++n) acc[a][b][m][n] = (f32x4){0.f, 0.f, 0.f, 0.f};
    bf16x8 At[4][2], B0[2][2], B1[2][2];
    const char* cA = (const char*)g.A + (size_t)cur.pm * tstep; const char* cB = (const char*)g.Bt + (size_t)cur.pn * tstep;
    S.a_ready(cur);
    const char* gA = (const char*)g.A;
    if constexpr (Sched::GATHER) { PG8_GATH(0, vgc);
        PG8_STAGE(PG8_SB(0, 0), cB, voffB); PG8_STAGE2(PG8_SA(0, 0), gA, vgc00, vgc01); PG8_STAGE(PG8_SB(0, 1), cB + hstep, voffB); PG8_STAGE2(PG8_SA(0, 1), gA, vgc10, vgc11); }
    else { PG8_STAGE(PG8_SB(0, 0), cB, voffB); PG8_STAGE(PG8_SA(0, 0), cA, voffA); PG8_STAGE(PG8_SB(0, 1), cB + hstep, voffB); PG8_STAGE(PG8_SA(0, 1), cA + hstep, voffA); }
    if (wr == 1) PG8_BAR;
    PG8_WAIT_V(4); PG8_BAR;
    if constexpr (Sched::GATHER) { PG8_STAGE(PG8_SB(1, 0), cB + kstep, voffB); PG8_STAGE2(PG8_SA(1, 0), gA + kstep, vgc00, vgc01); PG8_STAGE(PG8_SB(1, 1), cB + hstep + kstep, voffB); }
    else { PG8_STAGE(PG8_SB(1, 0), cB + kstep, voffB); PG8_STAGE(PG8_SA(1, 0), cA + kstep, voffA); PG8_STAGE(PG8_SB(1, 1), cB + hstep + kstep, voffB); }
    PG8_WAIT_V(6); PG8_BAR;
    PG8_STAMP();
    for (;;) {
        const bool has_next = S.next(ui + 1, nxt);
        const char* nA = has_next ? (const char*)g.A + (size_t)nxt.pm * tstep : cA; const char* nB = has_next ? (const char*)g.Bt + (size_t)nxt.pn * tstep : cB;
        if constexpr (Sched::GATHER) { if (has_next) PG8_GATH(ui + 1, vgn); else { vgn00 = vgc00; vgn01 = vgc01; vgn10 = vgc10; vgn11 = vgc11; } }
        for (int t = 0; t < nt; t += 2) {
            const bool last = (t == nt - 2);
            const char* a1 = cA + (size_t)(t + 1) * kstep;
            const char* a2 = last ? nA : cA + (size_t)(t + 2) * kstep; const char* b2 = last ? nB : cB + (size_t)(t + 2) * kstep;
            const char* a3 = a2 + kstep; const char* b3 = b2 + kstep;
            if (last && has_next) S.a_ready(nxt);
            const char* g1 = gA + (size_t)(t + 1) * kstep; const char* g2 = last ? gA : gA + (size_t)(t + 2) * kstep; const char* g3 = g2 + kstep;
            const unsigned s00 = last ? vgn00 : vgc00, s01 = last ? vgn01 : vgc01, s10 = last ? vgn10 : vgc10, s11 = last ? vgn11 : vgc11;
            PG8_LDB(B0, 0, 0); PG8_SCHED; PG8_LDA(At, 0, 0); if constexpr (Sched::GATHER) PG8_STAGE2(PG8_SA(1, 1), g1, vgc10, vgc11); else PG8_STAGE(PG8_SA(1, 1), a1 + hstep, voffA);
            PG8_WAIT_L(8); PG8_BAR; PG8_WAIT_L(0); PG8_MMA(0, 0, At, B0); PG8_BAR; PG8_SCHED;
            PG8_LDB(B1, 0, 1); PG8_STAGE(PG8_SB(0, 0), b2, voffB);
            PG8_BAR; PG8_WAIT_L(0); PG8_MMA(0, 1, At, B1); PG8_BAR;
            PG8_LDA(At, 0, 1); if constexpr (Sched::GATHER) PG8_STAGE2(PG8_SA(0, 0), g2, s00, s01); else PG8_STAGE(PG8_SA(0, 0), a2, voffA);
            PG8_BAR; PG8_WAIT_L(0); PG8_MMA(1, 0, At, B0); PG8_BAR; PG8_SCHED;
            PG8_STAGE(PG8_SB(0, 1), b2 + hstep, voffB);
            PG8_WAIT_V(6); PG8_BAR; PG8_MMA(1, 1, At, B1); PG8_BAR;
            PG8_LDB(B0, 1, 0); PG8_SCHED; PG8_LDA(At, 1, 0); if constexpr (Sched::GATHER) PG8_STAGE2(PG8_SA(0, 1), g2, s10, s11); else PG8_STAGE(PG8_SA(0, 1), a2 + hstep, voffA);
            PG8_WAIT_L(8); PG8_BAR; PG8_WAIT_L(0); PG8_MMA(0, 0, At, B0); PG8_BAR; PG8_SCHED;
            PG8_LDB(B1, 1, 1); PG8_STAGE(PG8_SB(1, 0), b3, voffB);
            PG8_BAR; PG8_WAIT_L(0); PG8_MMA(0, 1, At, B1); PG8_BAR;
            PG8_LDA(At, 1, 1); if constexpr (Sched::GATHER) PG8_STAGE2(PG8_SA(1, 0), g3, s00, s01); else PG8_STAGE(PG8_SA(1, 0), a3, voffA);
            PG8_BAR; PG8_WAIT_L(0); PG8_MMA(1, 0, At, B0); PG8_BAR; PG8_SCHED;
            PG8_STAGE(PG8_SB(1, 1), b3 + hstep, voffB);
            PG8_WAIT_V(6); PG8_BAR; PG8_MMA(1, 1, At, B1); PG8_BAR;
        }
        PG8_STAMP();
        if constexpr (!Epi::AFTER_DRAIN) { E(acc, cur, wr, wc, fr, fq); S.done(cur); }
        PG8_STAMP();
        if (!has_next) break;
#pragma unroll
        for (int a = 0; a < 2; ++a)
#pragma unroll
            for (int b = 0; b < 2; ++b)
#pragma unroll
                for (int m = 0; m < 4; ++m)
#pragma unroll
                    for (int n = 0; n < 2; ++n) acc[a][b][m][n] = (f32x4){0.f, 0.f, 0.f, 0.f};
        cur = nxt; cA = nA; cB = nB; ++ui;
        if constexpr (Sched::GATHER) { vgc00 = vgn00; vgc01 = vgn01; vgc10 = vgn10; vgc11 = vgn11; }
    }
    PG8_WAIT_V(0);
    if (wr == 0) PG8_BAR;
    PG8_BAR;
    if constexpr (Epi::AFTER_DRAIN) { E.fused(acc, cur, wr, wc, fr, fq, lds, wid, lane); S.done(cur); }
    PG8_STAMP();
    if (STAMP && wid == 0) { stamps[lane] = lane < nts ? (((unsigned long long)(unsigned)ts_hi << 32) | (unsigned)ts_lo) : 0ull;
        if (lane == 62) stamps[62] = rt_entry; if (lane == 63) stamps[63] = (unsigned long long)wall_clock64(); }
#undef PG8_STAMP
#undef PG8_SA
#undef PG8_SB
#undef PG8_STAGE
#undef PG8_STAGE2
#undef PG8_GATH
#undef PG8_LDA
#undef PG8_LDB
#undef PG8_MMA
#undef PG8_WAIT_V
#undef PG8_WAIT_L
#undef PG8_BAR
#undef PG8_SCHED
}
}
struct EpiStore {
    static constexpr bool PERM = true, AFTER_DRAIN = false;
    bf16_t* O; int ldc; int pn_mask;
    __device__ __forceinline__ void operator()(const pg8::f32x4 (&acc)[2][2][4][2], const pg8::Unit& u, int wr, int wc, int fr, int fq) const {
        const int row0 = u.pm * 256 + wr * 64 + fr, col0 = (u.pn & pn_mask) * 256 + wc * 32 + 8 * fq;
#pragma unroll
        for (int ai = 0; ai < 2; ++ai)
#pragma unroll
            for (int m = 0; m < 4; ++m) { bf16_t* rowp = O + (size_t)(row0 + ai * 128 + m * 16) * ldc + col0;
#pragma unroll
                for (int bj = 0; bj < 2; ++bj) { const pg8::f32x4 v0 = acc[ai][bj][m][0], v1 = acc[ai][bj][m][1];
                    pg8::u32x4 w; w.x = pg8::cvt_pk_bf16(v0[0], v0[1]); w.y = pg8::cvt_pk_bf16(v0[2], v0[3]); w.z = pg8::cvt_pk_bf16(v1[0], v1[1]); w.w = pg8::cvt_pk_bf16(v1[2], v1[3]);
                    *(pg8::u32x4*)(rowp + bj * 128) = w; } }
    }
};
__device__ __forceinline__ float silu_f(float g) { return g * __builtin_amdgcn_rcpf(1.0f + __expf(-g)); }
struct EpiGateUp {
    static constexpr bool PERM = true, AFTER_DRAIN = false;
    bf16_t* O;
    __device__ __forceinline__ void operator()(const pg8::f32x4 (&acc)[2][2][4][2], const pg8::Unit& u, int wr, int wc, int fr, int fq) const {
        const int row0 = u.pm * 256 + wr * 64 + fr, col0 = (u.pn & 3) * 128 + wc * 32 + 8 * fq;
#pragma unroll
        for (int ai = 0; ai < 2; ++ai)
#pragma unroll
            for (int m = 0; m < 4; ++m) { bf16_t* rowp = O + (size_t)(row0 + ai * 128 + m * 16) * DEXP + col0;
                const pg8::f32x4 g0 = acc[ai][0][m][0], g1 = acc[ai][0][m][1], u0 = acc[ai][1][m][0], u1 = acc[ai][1][m][1];
                pg8::u32x4 w;
                w.x = pg8::cvt_pk_bf16(silu_f(g0[0]) * u0[0], silu_f(g0[1]) * u0[1]); w.y = pg8::cvt_pk_bf16(silu_f(g0[2]) * u0[2], silu_f(g0[3]) * u0[3]);
                w.z = pg8::cvt_pk_bf16(silu_f(g1[0]) * u1[0], silu_f(g1[1]) * u1[1]); w.w = pg8::cvt_pk_bf16(silu_f(g1[2]) * u1[2], silu_f(g1[3]) * u1[3]);
                *(pg8::u32x4*)rowp = w; }
    }
};
struct EpiOutProj {
    static constexpr bool PERM = true, AFTER_DRAIN = false;
    bf16_t* O; const float* modl;
    __device__ __forceinline__ void operator()(const pg8::f32x4 (&acc)[2][2][4][2], const pg8::Unit& u, int wr, int wc, int fr, int fq) const {
        const int b = u.pm / 9, tb = u.pm % 9; const bool lat = tb < 8;
        const float* g1 = modl + (size_t)(lat ? b : 4) * 6 * D_ + 2 * D_;
        const int row0 = u.pm * 256 + wr * 64 + fr, col0 = u.pn * 256 + wc * 32 + 8 * fq;
        pg8::f32x4 gv[2][2];
#pragma unroll
        for (int bj = 0; bj < 2; ++bj)
#pragma unroll
            for (int n = 0; n < 2; ++n) gv[bj][n] = *(const pg8::f32x4*)(g1 + col0 + bj * 128 + 4 * n);
#pragma unroll
        for (int ai = 0; ai < 2; ++ai)
#pragma unroll
            for (int m = 0; m < 4; ++m) { bf16_t* rowp = O + (size_t)(row0 + ai * 128 + m * 16) * D_ + col0;
#pragma unroll
                for (int bj = 0; bj < 2; ++bj) { const pg8::f32x4 v0 = acc[ai][bj][m][0] * gv[bj][0], v1 = acc[ai][bj][m][1] * gv[bj][1];
                    pg8::u32x4 w; w.x = pg8::cvt_pk_bf16(v0[0], v0[1]); w.y = pg8::cvt_pk_bf16(v0[2], v0[3]); w.z = pg8::cvt_pk_bf16(v1[0], v1[1]); w.w = pg8::cvt_pk_bf16(v1[2], v1[3]);
                    *(pg8::u32x4*)(rowp + bj * 128) = w; } }
    }
};
struct EpiKVNorm {
    static constexpr bool PERM = true, AFTER_DRAIN = true;
    bf16_t* kv2; bf16_t* KC; const float* gk;
    __device__ __forceinline__ void operator()(const pg8::f32x4 (&)[2][2][4][2], const pg8::Unit&, int, int, int, int) const {}
    __device__ __forceinline__ void fused(const pg8::f32x4 (&acc)[2][2][4][2], const pg8::Unit& u, int wr, int wc, int fr, int fq, PG8_LAS unsigned char* lds, int wid, int lane) const {
        PG8_LAS float* part = (PG8_LAS float*)lds;
        const int h = u.pn;
#pragma unroll
        for (int ai = 0; ai < 2; ++ai)
#pragma unroll
            for (int m = 0; m < 4; ++m) { const pg8::f32x4 a = acc[ai][0][m][0], b = acc[ai][0][m][1];
                float ss = a[0] * a[0] + a[1] * a[1] + a[2] * a[2] + a[3] * a[3] + b[0] * b[0] + b[1] * b[1] + b[2] * b[2] + b[3] * b[3];
                ss += shx(ss, 16); ss += shx(ss, 32);
                if (fq == 0) part[(ai * 128 + wr * 64 + m * 16 + fr) * 4 + wc] = ss; }
        __syncthreads();
        const int col = wc * 32 + 8 * fq;
        const pg8::f32x4 g0 = *(const pg8::f32x4*)(gk + col), g1 = *(const pg8::f32x4*)(gk + col + 4);
#pragma unroll
        for (int ai = 0; ai < 2; ++ai)
#pragma unroll
            for (int m = 0; m < 4; ++m) { const int rl = ai * 128 + wr * 64 + m * 16 + fr; const size_t row = (size_t)u.pm * 256 + rl;
                const pg8::f32x4 pp = *(const PG8_LAS pg8::f32x4*)(part + rl * 4);
                const float rs = rsqrtf((pp[0] + pp[1] + pp[2] + pp[3]) * (1.0f / 128.0f) + EPS);
                const pg8::f32x4 k0 = acc[ai][0][m][0] * rs * g0, k1 = acc[ai][0][m][1] * rs * g1, v0 = acc[ai][1][m][0], v1 = acc[ai][1][m][1];
                pg8::u32x4 w; w.x = pg8::cvt_pk_bf16(k0[0], k0[1]); w.y = pg8::cvt_pk_bf16(k0[2], k0[3]); w.z = pg8::cvt_pk_bf16(k1[0], k1[1]); w.w = pg8::cvt_pk_bf16(k1[2], k1[3]);
                *(pg8::u32x4*)(KC + row * 768 + h * 192 + col) = w;
                w.x = pg8::cvt_pk_bf16(v0[0], v0[1]); w.y = pg8::cvt_pk_bf16(v0[2], v0[3]); w.z = pg8::cvt_pk_bf16(v1[0], v1[1]); w.w = pg8::cvt_pk_bf16(v1[2], v1[3]);
                *(pg8::u32x4*)(kv2 + row * 1024 + h * 256 + 128 + col) = w; }
    }
};
struct MapOrder : pg8::StaticOrder {
    int skipctx;
    __device__ bool next(int i, pg8::Unit& u) const { if (!pg8::StaticOrder::next(i, u)) return false; if (skipctx) u.pm = (u.pm >> 3) * 9 + (u.pm & 7); return true; }
};
struct MoeOrder {
    static constexpr bool GATHER = false;
    const PG8_LAS int* tab; int nN, G, c;
    __device__ bool next(int i, pg8::Unit& u) const {
        const long L = (long)i * G + c; const int ntile = tab[0];
        if (L >= (long)ntile * nN) return false;
        const int tile = (int)(L / nN), j = (int)(L % nN);
        u.pm = tile; u.pn = tab[8 + tile] * nN + j; return true;
    }
    __device__ __forceinline__ void a_ready(const pg8::Unit&) const {}
    __device__ __forceinline__ void done(const pg8::Unit&) const {}
};
struct MoeGatherOrder {
    static constexpr bool GATHER = true;
    const PG8_LAS int* tab; int nN, G, c; const PG8_LAS int* rows;
    __device__ bool next(int i, pg8::Unit& u) const {
        const long L = (long)i * G + c; const int ntile = tab[0];
        if (L >= (long)ntile * nN) return false;
        const int tile = (int)(L / nN), j = (int)(L % nN);
        u.pm = tile; u.pn = tab[8 + tile] * nN + j; return true;
    }
    __device__ __forceinline__ int row(int ui, int r) const { return rows[(ui & 3) * 256 + r]; }
    __device__ __forceinline__ void a_ready(const pg8::Unit&) const {}
    __device__ __forceinline__ void done(const pg8::Unit&) const {}
};
namespace att {
#define ATT_LAS __attribute__((address_space(3)))
using bf16x8 = __attribute__((ext_vector_type(8))) short;
using s16x4  = __attribute__((ext_vector_type(4))) short;
using f32x16 = __attribute__((ext_vector_type(16))) float;
using u32x4  = __attribute__((ext_vector_type(4))) unsigned;
using u32x2  = __attribute__((ext_vector_type(2))) unsigned;
constexpr int QBLK = 32, KVBLK = 64, SHM_V = KVBLK * 128 * 2;
constexpr float THR2 = 11.0f;
#define ATT_SBAR() __builtin_amdgcn_sched_barrier(0)
__device__ __forceinline__ int crow(int r, int hi) { return (r & 3) + 8 * (r >> 2) + 4 * hi; }
__device__ __forceinline__ unsigned cvtpk(float lo, float hi) { unsigned r; asm volatile("v_cvt_pk_bf16_f32 %0, %1, %2" : "=v"(r) : "v"(lo), "v"(hi)); return r; }

__device__ __forceinline__ void mask_tile(f32x16& p0, f32x16& p1, int dq) {
    const float NEG = -__builtin_inff();
#pragma unroll
    for (int r = 0; r < 16; ++r) {
        const int c = (r & 3) + 8 * (r >> 2);
        if ((unsigned)(dq - c) >= 257u) p0[r] = NEG;
        if ((unsigned)(dq - c - 32) >= 257u) p1[r] = NEG;
    }
}
__device__ __forceinline__ void partialSM(f32x16& p0, f32x16& p1, float& m_reg, float& mn, float& alpha) {
    float pmax = p0[0];
#pragma unroll
    for (int r = 1; r < 16; ++r) pmax = fmaxf(pmax, p0[r]);
#pragma unroll
    for (int r = 0; r < 16; ++r) pmax = fmaxf(pmax, p1[r]);
    { auto rr = __builtin_amdgcn_permlane32_swap(__float_as_uint(pmax), __float_as_uint(pmax), false, false);
      pmax = fmaxf(__uint_as_float(rr[0]), __uint_as_float(rr[1])); }
    if (__builtin_expect(__all(pmax - m_reg <= THR2), 1)) { mn = m_reg; alpha = 1.f; }
    else { mn = fmaxf(m_reg, pmax); alpha = __builtin_amdgcn_exp2f(m_reg - mn); m_reg = mn; }
#pragma unroll
    for (int r = 0; r < 16; ++r) p0[r] = p0[r] - mn;
#pragma unroll
    for (int r = 0; r < 16; ++r) p1[r] = p1[r] - mn;
#pragma unroll
    for (int r = 0; r < 16; ++r) p0[r] = __builtin_amdgcn_exp2f(p0[r]);
}
__device__ __forceinline__ void finishSM(f32x16& p0, f32x16& p1, float alpha, float& l_reg, bf16x8& pa0, bf16x8& pa1, bf16x8& pa2, bf16x8& pa3) {
#pragma unroll
    for (int r = 0; r < 16; ++r) p1[r] = __builtin_amdgcn_exp2f(p1[r]);
    float ps = 0;
#pragma unroll
    for (int r = 0; r < 16; ++r) ps += p0[r];
#pragma unroll
    for (int r = 0; r < 16; ++r) ps += p1[r];
    { auto rr = __builtin_amdgcn_permlane32_swap(__float_as_uint(ps), __float_as_uint(ps), false, false);
      ps = __uint_as_float(rr[0]) + __uint_as_float(rr[1]); }
    l_reg = l_reg * alpha + ps;
#define ATT_PK4(P, BASE, OUT) do { unsigned a0 = cvtpk(P[BASE + 0], P[BASE + 1]), a1 = cvtpk(P[BASE + 2], P[BASE + 3]);   \
    unsigned b0 = cvtpk(P[BASE + 4], P[BASE + 5]), b1 = cvtpk(P[BASE + 6], P[BASE + 7]);                              \
    auto r0 = __builtin_amdgcn_permlane32_swap(a0, b0, false, false); auto r1 = __builtin_amdgcn_permlane32_swap(a1, b1, false, false); \
    u32x4 w = {r0[0], r1[0], r0[1], r1[1]}; OUT = *reinterpret_cast<bf16x8*>(&w); } while (0)
    ATT_PK4(p0, 0, pa0); ATT_PK4(p0, 8, pa1); ATT_PK4(p1, 0, pa2); ATT_PK4(p1, 8, pa3);
#undef ATT_PK4
}
template <int DQK, int QL> __device__ __forceinline__ void qkt(f32x16& p0, f32x16& p1, const ATT_LAS unsigned char* Ks, const bf16x8 (&qr)[DQK / 16 - QL], const ATT_LAS unsigned char* Qs, int r32, int hi) {
    constexpr int KROW = 2 * DQK + 16;
    p0 = f32x16{}; p1 = f32x16{};
    if (QL > 0) asm volatile("" : "+v"(Qs));
#pragma unroll
    for (int d0 = 0; d0 < DQK / 16; ++d0) { const int cb = (d0 * 16 + hi * 8) * 2;
        const bf16x8 b0 = *reinterpret_cast<const ATT_LAS bf16x8*>(Ks + r32 * KROW + cb);
        const bf16x8 b1 = *reinterpret_cast<const ATT_LAS bf16x8*>(Ks + (32 + r32) * KROW + cb);
        bf16x8 q;
        if (d0 < DQK / 16 - QL) q = qr[d0 < DQK / 16 - QL ? d0 : 0];
        else q = *reinterpret_cast<const ATT_LAS bf16x8*>(Qs + (d0 - (DQK / 16 - QL)) * 32);
        p0 = __builtin_amdgcn_mfma_f32_32x32x16_bf16(b0, q, p0, 0, 0, 0);
        p1 = __builtin_amdgcn_mfma_f32_32x32x16_bf16(b1, q, p1, 0, 0, 0);
        if (DQK > 128 && (d0 & 3) == 3) ATT_SBAR(); }
}
__device__ __forceinline__ int v_st(int k, int c) { const int kk = (k & ~0xC) | ((k & 4) << 1) | ((k & 8) >> 1); return ((kk >> 3) * 4 + (c >> 5)) * 512 + ((kk & 7) * 32 + (c & 31)) * 2; }
__device__ __forceinline__ int v_rd_base(int lane) { return ((lane & 3) << 3) | (((lane >> 2) & 3) << 6) | (((lane >> 4) & 1) << 5) | (((lane >> 5) & 1) << 8); }
constexpr int v_rd_off(int d0, int ks, int half) { return d0 * 512 + ks * 4096 + half * 2048; }
template <int OFF> __device__ __forceinline__ s16x4 tr_read(int vb) {
    s16x4 r; asm volatile("ds_read_b64_tr_b16 %0, %1 offset:%2" : "=&v"(r) : "v"(vb), "i"(OFF) : "memory"); return r;
}
template <int D0> __device__ __forceinline__ void pv_one(f32x16& od, int vb, bf16x8 pa0, bf16x8 pa1, bf16x8 pa2, bf16x8 pa3) {
    const s16x4 l0 = tr_read<v_rd_off(D0, 0, 0)>(vb), h0 = tr_read<v_rd_off(D0, 0, 1)>(vb), l1 = tr_read<v_rd_off(D0, 1, 0)>(vb), h1 = tr_read<v_rd_off(D0, 1, 1)>(vb);
    const s16x4 l2 = tr_read<v_rd_off(D0, 2, 0)>(vb), h2 = tr_read<v_rd_off(D0, 2, 1)>(vb), l3 = tr_read<v_rd_off(D0, 3, 0)>(vb), h3 = tr_read<v_rd_off(D0, 3, 1)>(vb);
    asm volatile("s_waitcnt lgkmcnt(0)" ::: "memory"); ATT_SBAR();
#define ATT_PK(L, H) (bf16x8){L[0], L[1], L[2], L[3], H[0], H[1], H[2], H[3]}
    od = __builtin_amdgcn_mfma_f32_32x32x16_bf16(pa0, ATT_PK(l0, h0), od, 0, 0, 0);
    od = __builtin_amdgcn_mfma_f32_32x32x16_bf16(pa1, ATT_PK(l1, h1), od, 0, 0, 0);
    od = __builtin_amdgcn_mfma_f32_32x32x16_bf16(pa2, ATT_PK(l2, h2), od, 0, 0, 0);
    od = __builtin_amdgcn_mfma_f32_32x32x16_bf16(pa3, ATT_PK(l3, h3), od, 0, 0, 0);
#undef ATT_PK
}
__device__ __forceinline__ void pv_d0(f32x16 (&o)[4], int vb, bf16x8 pa0, bf16x8 pa1, bf16x8 pa2, bf16x8 pa3) {
    pv_one<0>(o[0], vb, pa0, pa1, pa2, pa3); pv_one<1>(o[1], vb, pa0, pa1, pa2, pa3); pv_one<2>(o[2], vb, pa0, pa1, pa2, pa3); pv_one<3>(o[3], vb, pa0, pa1, pa2, pa3);
}
template <int DQK> constexpr int lds_bytes() { return 2 * SHM_V + 2 * 64 * (2 * DQK + 16) + 8 * 64 * 4 + 256 * 176; }

template <int DQK, bool MASK, int SD, int QL>
__device__ __forceinline__ void attn_body(ATT_LAS unsigned char* lds, const bf16_t* __restrict__ Qb, int ldq, const bf16_t* __restrict__ Kh, int ldk,
                                          const bf16_t* __restrict__ Vh, int ldv, int nt, int n0, int s0, int s1, int qpos0, int rot,
                                          f32x16 (&o)[4], float& m_reg, float& l_reg) {
    constexpr int KROW = 2 * DQK + 16, SHM_K = 64 * KROW, NCH = DQK / 8, KPT = DQK / 64;
    const int tid = lid(), wid = __builtin_amdgcn_readfirstlane(tid >> 6), lane = tid & 63, r32 = lane & 31, hi = lane >> 5;
    ATT_LAS unsigned char* V_lds = lds; ATT_LAS unsigned char* K_lds = lds + 2 * SHM_V;
    ATT_LAS float* al_l = (ATT_LAS float*)(lds + 2 * SHM_V + 2 * SHM_K) + wid * 64 + 32;
    m_reg = -1e30f; l_reg = 0.f;
#pragma unroll
    for (int d = 0; d < 4; ++d) o[d] = f32x16{};
    bf16x8 qr[DQK / 16 - QL];
    const bf16_t* Qw = Qb + (size_t)(wid * QBLK + r32) * ldq + hi * 8;
#pragma unroll
    for (int d0 = 0; d0 < DQK / 16 - QL; ++d0) qr[d0] = *reinterpret_cast<const bf16x8*>(Qw + d0 * 16);
    ATT_LAS unsigned char* Qs = lds + 2 * SHM_V + 2 * SHM_K + 8 * 64 * 4 + (wid * QBLK + r32) * (QL * 32 + 16) + hi * 16;
#pragma unroll
    for (int d0 = 0; d0 < QL; ++d0) *reinterpret_cast<ATT_LAS bf16x8*>(Qs + d0 * 32) = *reinterpret_cast<const bf16x8*>(Qw + (DQK / 16 - QL + d0) * 16);
    const int sr = tid >> 4, sc = (tid & 15) * 8, vst0 = v_st(sr, sc), vst1 = v_st(32 + sr, sc);
    const unsigned vo0 = (unsigned)(sr * ldv + sc), vo1 = vo0 + 32u * (unsigned)ldv;
    unsigned ko_[KPT]; int kw_[KPT];
#pragma unroll
    for (int i = 0; i < KPT; ++i) { const int c = tid + 512 * i, kr = c / NCH, kc = (c % NCH) * 8; ko_[i] = (unsigned)(kr * ldk + kc); kw_[i] = kr * KROW + kc * 2; }
    const int vb0 = (int)(unsigned)(uintptr_t)V_lds + v_rd_base(lane);
    const int qm = qpos0 + wid * QBLK + r32 + 128 - 4 * hi;
    struct Slot { bf16x8 vs0, vs1, ks[KPT]; };
    Slot sA, sB;
#define ATT_KB(j) ((j) < n0 ? s0 + 64 * (((j) + rot) >= n0 ? (j) + rot - n0 : (j) + rot) : s1 + 64 * ((j) - n0))
#define ATT_SLOAD(S, j) do { const int kb_ = ATT_KB(j); const bf16_t* vt_ = Vh + (size_t)kb_ * ldv; const bf16_t* kt_ = Kh + (size_t)kb_ * ldk; \
    S.vs0 = *reinterpret_cast<const bf16x8*>(vt_ + vo0); S.vs1 = *reinterpret_cast<const bf16x8*>(vt_ + vo1); \
    _Pragma("unroll") for (int i_ = 0; i_ < KPT; ++i_) S.ks[i_] = *reinterpret_cast<const bf16x8*>(kt_ + ko_[i_]); } while (0)
#define ATT_SWRITE(b, S) do { *reinterpret_cast<ATT_LAS bf16x8*>(V_lds + (b) * SHM_V + vst0) = S.vs0; *reinterpret_cast<ATT_LAS bf16x8*>(V_lds + (b) * SHM_V + vst1) = S.vs1; \
    _Pragma("unroll") for (int i_ = 0; i_ < KPT; ++i_) *reinterpret_cast<ATT_LAS bf16x8*>(K_lds + (b) * SHM_K + kw_[i_]) = S.ks[i_]; } while (0)
#define ATT_RESC(a) do { if (__any((a) < 1.f)) { if (hi == 0) al_l[r32] = (a); asm volatile("s_waitcnt lgkmcnt(0)" ::: "memory"); \
    _Pragma("unroll") for (int d = 0; d < 4; ++d) _Pragma("unroll") for (int r = 0; r < 16; ++r) o[d][r] *= al_l[crow(r, hi)]; } } while (0)
#define ATT_MASKT(P0_, P1_, j) do { if (MASK && (j) >= n0) mask_tile(P0_, P1_, qm - ATT_KB(j)); } while (0)
    f32x16 pA0, pA1, pB0, pB1; float mnA, mnB, alA, alB; bf16x8 pa0, pa1, pa2, pa3; const int NT = nt;
    ATT_SLOAD(sA, 0); asm volatile("s_waitcnt vmcnt(0)" ::: "memory"); ATT_SWRITE(0, sA); __syncthreads();
    qkt<DQK, QL>(pA0, pA1, K_lds, qr, Qs, r32, hi); ATT_MASKT(pA0, pA1, 0); partialSM(pA0, pA1, m_reg, mnA, alA);
    if constexpr (SD == 2) { ATT_SLOAD(sB, 1); ATT_SLOAD(sA, 2); ATT_SWRITE(1, sB); } else { ATT_SLOAD(sA, 1); ATT_SWRITE(1, sA); }
    __syncthreads();
    for (int j = 1; j + 1 < NT; j += 2) {
        ATT_SBAR(); qkt<DQK, QL>(pB0, pB1, K_lds + SHM_K, qr, Qs, r32, hi);
        finishSM(pA0, pA1, alA, l_reg, pa0, pa1, pa2, pa3); ATT_SBAR();
        if constexpr (SD == 2) { ATT_SLOAD(sB, j + 2); } else { ATT_SLOAD(sA, j + 1); }
        ATT_SBAR();
        pv_d0(o, vb0, pa0, pa1, pa2, pa3); ATT_MASKT(pB0, pB1, j); partialSM(pB0, pB1, m_reg, mnB, alB);
        __syncthreads(); ATT_SWRITE(0, sA);
        ATT_RESC(alB); __syncthreads();
        ATT_SBAR(); qkt<DQK, QL>(pA0, pA1, K_lds, qr, Qs, r32, hi);
        finishSM(pB0, pB1, alB, l_reg, pa0, pa1, pa2, pa3); ATT_SBAR();
        if constexpr (SD == 2) { if (j + 3 < NT) ATT_SLOAD(sA, j + 3); } else { ATT_SLOAD(sA, j + 2); }
        ATT_SBAR();
        pv_d0(o, vb0 + SHM_V, pa0, pa1, pa2, pa3); ATT_MASKT(pA0, pA1, j + 1); partialSM(pA0, pA1, m_reg, mnA, alA);
        __syncthreads(); if constexpr (SD == 2) { ATT_SWRITE(1, sB); } else { ATT_SWRITE(1, sA); }
        ATT_RESC(alA); __syncthreads();
    }
    ATT_SBAR(); qkt<DQK, QL>(pB0, pB1, K_lds + SHM_K, qr, Qs, r32, hi);
    finishSM(pA0, pA1, alA, l_reg, pa0, pa1, pa2, pa3); ATT_SBAR();
    pv_d0(o, vb0, pa0, pa1, pa2, pa3); ATT_MASKT(pB0, pB1, NT - 1); partialSM(pB0, pB1, m_reg, mnB, alB);
    __syncthreads(); ATT_RESC(alB);
    finishSM(pB0, pB1, alB, l_reg, pa0, pa1, pa2, pa3); ATT_SBAR();
    pv_d0(o, vb0 + SHM_V, pa0, pa1, pa2, pa3);
#undef ATT_KB
#undef ATT_SLOAD
#undef ATT_SWRITE
#undef ATT_RESC
#undef ATT_MASKT
}
__device__ __forceinline__ void cvt8(const bf16x8 q, float (&v)[8]) {
#pragma unroll
    for (int i = 0; i < 8; ++i) v[i] = __uint_as_float(((unsigned)(unsigned short)q[i]) << 16);
}
__device__ __forceinline__ bf16x8 pk8(const float (&v)[8]) { u32x4 w = {cvtpk(v[0], v[1]), cvtpk(v[2], v[3]), cvtpk(v[4], v[5]), cvtpk(v[6], v[7])}; return *reinterpret_cast<bf16x8*>(&w); }
__device__ __forceinline__ void qc_prep(bf16x8 (&qr)[12], const float* gq, const float* cA, const float* sA, int t, bool lat, int hi, float scale) {
    float ssn = 0.f, ssr = 0.f;
#pragma unroll
    for (int d0 = 0; d0 < 12; ++d0) { float v[8]; cvt8(qr[d0], v); float s_ = 0.f;
#pragma unroll
        for (int i = 0; i < 8; ++i) s_ += v[i] * v[i];
        if (d0 < 8) ssn += s_; else ssr += s_; }
    ssn += shx(ssn, 32); ssr += shx(ssr, 32);
    const float rn = rsqrtf(ssn * (1.0f / 128.0f) + 1e-6f), rr = rsqrtf(ssr * (1.0f / 64.0f) + 1e-6f);
#pragma unroll
    for (int d0 = 0; d0 < 8; ++d0) { float v[8]; cvt8(qr[d0], v); const float* gp = gq + d0 * 16 + hi * 8;
#pragma unroll
        for (int i = 0; i < 8; ++i) v[i] = v[i] * rn * gp[i] * scale;
        qr[d0] = pk8(v); }
#pragma unroll
    for (int dd = 0; dd < 2; ++dd) { float lo[8], up[8]; cvt8(qr[8 + dd], lo); cvt8(qr[10 + dd], up);
        const float* gl = gq + 128 + dd * 16 + hi * 8; const float* gu = gl + 32; const float* cp = cA + (size_t)t * 32 + dd * 16 + hi * 8; const float* sp = sA + (size_t)t * 32 + dd * 16 + hi * 8;
#pragma unroll
        for (int i = 0; i < 8; ++i) { float a = lo[i] * rr * gl[i], b = up[i] * rr * gu[i];
            if (lat) { const float c = cp[i], s_ = sp[i]; const float na = a * c - b * s_, nb_ = b * c + a * s_; a = na; b = nb_; }
            lo[i] = a * scale; up[i] = b * scale; }
        qr[8 + dd] = pk8(lo); qr[10 + dd] = pk8(up); }
}
template <int DQK, bool MASK, int PD, bool QN = false>
__device__ __forceinline__ void attn_body_np(ATT_LAS unsigned char* lds, const bf16_t* __restrict__ Qb, int ldq, const bf16_t* __restrict__ Kh, int ldk,
                                             const bf16_t* __restrict__ Vh, int ldv, int nt, int n0, int s0, int s1, int qpos0, int rot,
                                             f32x16 (&o)[4], float& m_reg, float& l_reg, const float* gq = nullptr, const float* cA = nullptr, const float* sA = nullptr, bool lat = false, float qscale = 1.0f) {
    constexpr int KROW = 2 * DQK + 16, SHM_K = 64 * KROW, NCH = DQK / 8, KPT = DQK / 64;
    const int tid = lid(), wid = __builtin_amdgcn_readfirstlane(tid >> 6), lane = tid & 63, r32 = lane & 31, hi = lane >> 5;
    ATT_LAS unsigned char* V_lds = lds; ATT_LAS unsigned char* K_lds = lds + 2 * SHM_V;
    ATT_LAS float* al_l = (ATT_LAS float*)(lds + 2 * SHM_V + 2 * SHM_K) + wid * 64 + 32;
    m_reg = -1e30f; l_reg = 0.f;
#pragma unroll
    for (int d = 0; d < 4; ++d) o[d] = f32x16{};
    bf16x8 qr[DQK / 16];
    const bf16_t* Qw = Qb + (size_t)(wid * QBLK + r32) * ldq + hi * 8;
#pragma unroll
    for (int d0 = 0; d0 < DQK / 16; ++d0) qr[d0] = *reinterpret_cast<const bf16x8*>(Qw + d0 * 16);
    if constexpr (QN) { static_assert(DQK == 192, "group C"); qc_prep(qr, gq, cA, sA, qpos0 + wid * QBLK + r32, lat, hi, qscale); }
    const int sr = tid >> 4, sc = (tid & 15) * 8, vst0 = v_st(sr, sc), vst1 = v_st(32 + sr, sc);
    const unsigned vo0 = (unsigned)(sr * ldv + sc), vo1 = vo0 + 32u * (unsigned)ldv;
    unsigned ko_[KPT]; int kw_[KPT];
#pragma unroll
    for (int i = 0; i < KPT; ++i) { const int c = tid + 512 * i, kr = c / NCH, kc = (c % NCH) * 8; ko_[i] = (unsigned)(kr * ldk + kc); kw_[i] = kr * KROW + kc * 2; }
    const int vb0 = (int)(unsigned)(uintptr_t)V_lds + v_rd_base(lane);
    const int qm = qpos0 + wid * QBLK + r32 + 128 - 4 * hi;
    bf16x8 vs0[PD], vs1[PD], ks[PD][KPT];
#define ATT_KB(j) ((j) < n0 ? s0 + 64 * (((j) + rot) >= n0 ? (j) + rot - n0 : (j) + rot) : s1 + 64 * ((j) - n0))
#define ATT_SLOAD(S, j) do { const int kb_ = ATT_KB(j); const bf16_t* vt_ = Vh + (size_t)kb_ * ldv; const bf16_t* kt_ = Kh + (size_t)kb_ * ldk; \
    vs0[S] = *reinterpret_cast<const bf16x8*>(vt_ + vo0); vs1[S] = *reinterpret_cast<const bf16x8*>(vt_ + vo1); \
    _Pragma("unroll") for (int i_ = 0; i_ < KPT; ++i_) ks[S][i_] = *reinterpret_cast<const bf16x8*>(kt_ + ko_[i_]); } while (0)
#define ATT_SWRITE(b, S) do { *reinterpret_cast<ATT_LAS bf16x8*>(V_lds + (b) * SHM_V + vst0) = vs0[S]; *reinterpret_cast<ATT_LAS bf16x8*>(V_lds + (b) * SHM_V + vst1) = vs1[S]; \
    _Pragma("unroll") for (int i_ = 0; i_ < KPT; ++i_) *reinterpret_cast<ATT_LAS bf16x8*>(K_lds + (b) * SHM_K + kw_[i_]) = ks[S][i_]; } while (0)
#pragma unroll
    for (int d = 0; d < PD; ++d) if (d < nt) ATT_SLOAD(d, d);
    ATT_SWRITE(0, 0); __syncthreads();
    for (int j0 = 0; j0 < nt; j0 += PD) {
#pragma unroll
        for (int u = 0; u < PD; ++u) { const int j = j0 + u;
            if (j < nt) {
                const int buf = j & 1;
                if (j + PD < nt) ATT_SLOAD(u, j + PD);
                f32x16 p0, p1; float mn, al; bf16x8 pa0, pa1, pa2, pa3;
                ATT_SBAR();
                {   const ATT_LAS unsigned char* Ks = K_lds + buf * SHM_K;
                    p0 = f32x16{}; p1 = f32x16{};
#pragma unroll
                    for (int d0 = 0; d0 < DQK / 16; ++d0) { const int cb = (d0 * 16 + hi * 8) * 2;
                        const bf16x8 b0 = *reinterpret_cast<const ATT_LAS bf16x8*>(Ks + r32 * KROW + cb);
                        const bf16x8 b1 = *reinterpret_cast<const ATT_LAS bf16x8*>(Ks + (32 + r32) * KROW + cb);
                        p0 = __builtin_amdgcn_mfma_f32_32x32x16_bf16(b0, qr[d0], p0, 0, 0, 0);
                        p1 = __builtin_amdgcn_mfma_f32_32x32x16_bf16(b1, qr[d0], p1, 0, 0, 0);
                        if ((d0 & 3) == 3) ATT_SBAR(); } }
                if (MASK && j >= n0) mask_tile(p0, p1, qm - ATT_KB(j));
                partialSM(p0, p1, m_reg, mn, al);
                if (__any(al < 1.f)) { if (hi == 0) al_l[r32] = al; asm volatile("s_waitcnt lgkmcnt(0)" ::: "memory");
#pragma unroll
                    for (int d = 0; d < 4; ++d)
#pragma unroll
                        for (int r = 0; r < 16; ++r) o[d][r] *= al_l[crow(r, hi)]; }
                finishSM(p0, p1, al, l_reg, pa0, pa1, pa2, pa3); ATT_SBAR();
                pv_d0(o, vb0 + buf * SHM_V, pa0, pa1, pa2, pa3);
                if (j + 1 < nt) ATT_SWRITE(buf ^ 1, (u + 1) % PD);
                __syncthreads();
            } }
    }
#undef ATT_KB
#undef ATT_SLOAD
#undef ATT_SWRITE
}
}
#define LDS_TOTAL 147456
#define LDS_BAR_OFF 147200
#define LDS_TAB_OFF 145408
#define NPHASE 24
#define LDS_ROWS_OFF 135168

typedef float f32x4v __attribute__((ext_vector_type(4)));
__device__ __forceinline__ void ld8f(const bf16_t* p, float (&v)[8]) {
    const uint4 w = *(const uint4*)p; const unsigned u[4] = {w.x, w.y, w.z, w.w};
#pragma unroll
    for (int i = 0; i < 4; ++i) { v[2 * i] = __uint_as_float(u[i] << 16); v[2 * i + 1] = __uint_as_float(u[i] & 0xffff0000u); }
}
__device__ __forceinline__ void ld8g(const float* p, float (&v)[8]) {
    const f32x4v a = *(const f32x4v*)p, b = *(const f32x4v*)(p + 4);
    v[0] = a[0]; v[1] = a[1]; v[2] = a[2]; v[3] = a[3]; v[4] = b[0]; v[5] = b[1]; v[6] = b[2]; v[7] = b[3];
}
__device__ __forceinline__ void st8bf(bf16_t* p, const float (&v)[8]) {
    uint4 w; w.x = pg8::cvt_pk_bf16(v[0], v[1]); w.y = pg8::cvt_pk_bf16(v[2], v[3]); w.z = pg8::cvt_pk_bf16(v[4], v[5]); w.w = pg8::cvt_pk_bf16(v[6], v[7]);
    *(uint4*)p = w;
}

__device__ __forceinline__ void st8bf_nt(bf16_t* p, const float (&v)[8]) {
    typedef unsigned u32x4v __attribute__((ext_vector_type(4)));
    u32x4v w; w.x = pg8::cvt_pk_bf16(v[0], v[1]); w.y = pg8::cvt_pk_bf16(v[2], v[3]); w.z = pg8::cvt_pk_bf16(v[4], v[5]); w.w = pg8::cvt_pk_bf16(v[6], v[7]);
    __builtin_nontemporal_store(w, (u32x4v*)p);
}
struct CT { const float* src; bf16_t* dst; int ld, ldd; bool pad; };
#define NT_GU   (64 * 256)
#define NT_DN   (64 * 256)
#define NT_WIN  (2 * 32 * 64)
#define NT_WOUT (2 * 32 * 32)
#define NT_WUQ  (2 * 8 * 12)
#define NT_WUKV (2 * 4 * 16)
#define NT_CONV (2 * NT_GU + NT_DN + NT_WIN + NT_WOUT + NT_WUQ + NT_WUKV)
#define NJ_CONV (NT_CONV / 4)
#define NJ_MOE (3 * NT_GU / 4)
#define NJ_DENSE (NJ_CONV - NJ_MOE)
#define NWORK 224
__device__ __forceinline__ int moe_job_tile(int j) { const int l = j / 6144, r = j % 6144, kind = r >> 11, m = r & 2047;
    return kind * NT_GU + (l * 32 * 256) + m * 4; }
template <class PT> __device__ __forceinline__ CT conv_decode(const PT& p, const float* wg, const float* wu, const float* wd, int g) {
    CT c; c.pad = false;
    if (g < 2 * NT_GU) { const int up = g >= NT_GU; if (up) g -= NT_GU;
        const int mat = g >> 8, tl = g & 255, kt = tl >> 3, nt = tl & 7, n0 = nt * 64;
        c.src = (up ? wu : wg) + (size_t)mat * D_ * DEXP + (size_t)(kt * 64) * DEXP + n0; c.ld = DEXP;
        c.dst = p.guT() + ((size_t)mat * 1024 + (n0 >> 7) * 256 + up * 128 + (n0 & 127)) * D_ + kt * 64; c.ldd = D_; return c; }
    g -= 2 * NT_GU;
    if (g < NT_DN) { const int mat = g >> 8, tl = g & 255, kt = tl >> 5, nt = tl & 31;
        c.src = wd + (size_t)mat * DEXP * D_ + (size_t)(kt * 64) * D_ + nt * 64; c.ld = D_;
        c.dst = p.dT() + ((size_t)mat * D_ + nt * 64) * DEXP + kt * 64; c.ldd = DEXP; return c; }
    g -= NT_DN;
    if constexpr (!PT::HAS_FIELDS) { return c; } else {
    if (g < NT_WIN) { const int l = g >> 11, tl = g & 2047, kt = tl >> 6, nt = tl & 63;
        c.pad = nt >= 61;
        c.src = p.w_in + (size_t)l * D_ * DIN + (size_t)(kt * 64) * DIN + (c.pad ? 0 : nt * 64); c.ld = DIN;
        c.dst = p.winT() + ((size_t)l * ZLD + nt * 64) * D_ + kt * 64; c.ldd = D_; return c; }
    g -= NT_WIN;
    if (g < NT_WOUT) { const int l = g >> 10, tl = g & 1023, kt = tl >> 5, nt = tl & 31;
        c.src = p.w_out + (size_t)l * D_ * D_ + (size_t)(kt * 64) * D_ + nt * 64; c.ld = D_;
        c.dst = p.woutT() + ((size_t)l * D_ + nt * 64) * D_ + kt * 64; c.ldd = D_; return c; }
    g -= NT_WOUT;
    if (g < NT_WUQ) { const int l = g / 96, tl = g % 96, kt = tl / 12, nt = tl % 12;
        c.src = p.c_wuq + (size_t)l * 512 * 768 + (size_t)(kt * 64) * 768 + nt * 64; c.ld = 768;
        c.dst = p.wuqT() + ((size_t)l * 768 + nt * 64) * 512 + kt * 64; c.ldd = 512; return c; }
    g -= NT_WUQ;
    { const int l = g >> 6, tl = g & 63, kt = tl >> 4, nt = tl & 15;
        c.src = p.c_wukv + (size_t)l * 256 * 1024 + (size_t)(kt * 64) * 1024 + nt * 64; c.ld = 1024;
        c.dst = p.wukvT() + ((size_t)l * 1024 + nt * 64) * 256 + kt * 64; c.ldd = 256; return c; }
    }
}
template <bool NT, class PT, class F> __device__ __forceinline__ void conv_pipe(const PT& p, const float* wg, const float* wu, const float* wd, int n, F tile_of, LAS float* T, int tid) {
    if (n <= 0) return;
    f32x4v a0[4], b0[4], a1[4], b1[4], a2[4], b2[4];
    const int kl = tid >> 3, nc = (tid & 7) * 8;
#define CONV_LOAD(A_, B_, g0_) do { _Pragma("unroll") for (int t = 0; t < 4; ++t) { const CT c = conv_decode(p, wg, wu, wd, (g0_) + t); \
        const float* sp = c.src + (size_t)kl * c.ld + nc; const f32x4v z4 = (f32x4v){0.f, 0.f, 0.f, 0.f}; \
        f32x4v la = z4, lb = z4; if (!c.pad) { if (NT) { la = __builtin_nontemporal_load((const f32x4v*)sp); lb = __builtin_nontemporal_load((const f32x4v*)(sp + 4)); } else { la = *(const f32x4v*)sp; lb = *(const f32x4v*)(sp + 4); } } A_[t] = la; B_[t] = lb; } } while (0)
#define CONV_STEP(A_, B_, k_) do { \
        _Pragma("unroll") for (int t = 0; t < 4; ++t) { LAS float* tp = T + t * (64 * 65) + kl * 65 + nc; \
            tp[0] = A_[t][0]; tp[1] = A_[t][1]; tp[2] = A_[t][2]; tp[3] = A_[t][3]; tp[4] = B_[t][0]; tp[5] = B_[t][1]; tp[6] = B_[t][2]; tp[7] = B_[t][3]; } \
        __syncthreads(); \
        const int g0s = tile_of(k_); \
        if ((k_) + 3 < n) CONV_LOAD(A_, B_, tile_of((k_) + 3)); \
        {   const int nn = tid >> 3, kc = (tid & 7) * 8; \
            _Pragma("unroll") for (int t = 0; t < 4; ++t) { const CT c = conv_decode(p, wg, wu, wd, g0s + t); float v[8]; \
                _Pragma("unroll") for (int i = 0; i < 8; ++i) v[i] = T[t * (64 * 65) + (kc + i) * 65 + nn]; \
                st8bf(c.dst + (size_t)nn * c.ldd + kc, v); } } \
        __syncthreads(); } while (0)
    CONV_LOAD(a0, b0, tile_of(0));
    if (1 < n) CONV_LOAD(a1, b1, tile_of(1));
    if (2 < n) CONV_LOAD(a2, b2, tile_of(2));
    for (int k = 0; k < n; k += 3) {
        CONV_STEP(a0, b0, k);
        if (k + 1 < n) CONV_STEP(a1, b1, k + 1);
        if (k + 2 < n) CONV_STEP(a2, b2, k + 2);
    }
#undef CONV_LOAD
#undef CONV_STEP
}
__device__ __forceinline__ void ph_prologue(const P& p, LAS unsigned char* lds, int bid, int nb) {
    const int tid = lid();
    for (int i = bid * 512 + tid; i < 2048 * 64; i += nb * 512) {
        const int t = i >> 6, j = i & 63; const float r = (float)(t >> 6), col = (float)(t & 63);
        if (j < 32) { const float inv = powf(10000.0f, -(float)(j & 15) / 16.0f), ang = (j < 16 ? r : col) * inv; p.cosA()[t * 32 + j] = cosf(ang); p.sinA()[t * 32 + j] = sinf(ang); }
        { const float inv = powf(10000.0f, -(float)(j & 31) / 32.0f), ang = (j < 32 ? r : col) * inv; p.cosB()[t * 64 + j] = cosf(ang); p.sinB()[t * 64 + j] = sinf(ang); }
    }
    for (int i = bid * 512 + tid; i < 2048 * 32; i += nb * 512) { const int k = i >> 5, e = i & 31; const float w = p.router_w[i];
        const bf16_t hi = f2bf(w); const bf16_t lo = f2bf(w - bf2f(hi)); p.rwT()[(size_t)e * 2048 + k] = hi; p.rwT()[(size_t)(32 + e) * 2048 + k] = lo; }
    for (int tile = bid; tile < 192; tile += nb) {
        LAS float* s = (LAS float*)lds;
        LAS float* red = s + 5 * D_;
        __syncthreads();
        for (int i = tid; i < 5 * D_; i += 512) { const int r = i >> 11, k = i & 2047; const float v = r < 4 ? p.c[r * D_ + k] : p.c_ctx[k]; s[i] = v / (1.0f + __expf(-v)); }
        __syncthreads();
        const int l = tile / 96, n0 = (tile % 96) * 128, cl = tid & 31, kg = tid >> 5;
        const float* w = p.ada_w + (size_t)l * D_ * 6 * D_ + (size_t)(kg * 128) * 6 * D_ + n0 + cl * 4;
        f32x4v acc[5];
#pragma unroll
        for (int r = 0; r < 5; ++r) acc[r] = (f32x4v){0.f, 0.f, 0.f, 0.f};
#pragma unroll 8
        for (int k = 0; k < 128; ++k) { const f32x4v wv = __builtin_nontemporal_load((const f32x4v*)(w + (size_t)k * 6 * D_));
#pragma unroll
            for (int r = 0; r < 5; ++r) acc[r] += wv * s[r * D_ + kg * 128 + k]; }
#pragma unroll
        for (int r = 0; r < 5; ++r) *(LAS f32x4v*)(red + (kg * 5 + r) * 128 + cl * 4) = acc[r];
        __syncthreads();
        for (int idx = tid; idx < 640; idx += 512) { const int r = idx >> 7, cc = idx & 127; float sum = p.ada_b[l * 6 * D_ + n0 + cc];
#pragma unroll
            for (int g2 = 0; g2 < 16; ++g2) sum += red[(g2 * 5 + r) * 128 + cc];
            p.mod()[((size_t)(l * 5 + r)) * 6 * D_ + n0 + cc] = sum; }
        __syncthreads();
    }
    LAS float* T = (LAS float*)lds;
    if (nb > 192) { const int nslot = 192 + 4 * (nb - 192);
        if (bid < 192) conv_pipe<true>(p, p.moe_w_gate, p.moe_w_up, p.moe_w_down, (NJ_DENSE - bid + nslot - 1) / nslot, [&](int k) { return 3 * NT_GU + (bid + k * nslot) * 4; }, T, tid);
        else { const int s0 = 192 + (bid - 192) * 4; int n = 0;
#pragma unroll
            for (int q = 0; q < 4; ++q) n += (NJ_DENSE - (s0 + q) + nslot - 1) / nslot;
            conv_pipe<true>(p, p.moe_w_gate, p.moe_w_up, p.moe_w_down, n, [&](int k) { return 3 * NT_GU + (s0 + (k & 3) + (k >> 2) * nslot) * 4; }, T, tid); } }
    else conv_pipe<true>(p, p.moe_w_gate, p.moe_w_up, p.moe_w_down, (NJ_DENSE - bid + nb - 1) / nb, [&](int k) { return 3 * NT_GU + (bid + k * nb) * 4; }, T, tid);
}
#ifndef NW_IN
#define NW_IN 192
#endif
#ifndef NW_OUT
#define NW_OUT 144
#endif
#ifndef NW_GU
#define NW_GU 208
#endif
__device__ __forceinline__ void bg_window(const Q& p, LAS unsigned char* lds, int ph, int nwork, int lq) {
    const int tid = lid();
    LAS int* jb = (LAS int*)(lds + LDS_TAB_OFF + 1280);
    LAS float* T = (LAS float*)lds;
    const float* wg = p.moe_w_gate(); const float* wu = p.moe_w_up(); const float* wd = p.moe_w_down();
    __syncthreads();
    for (;;) {
        if (tid == 0) { int j = -1;
            if (__hip_atomic_load(p.pdone(ph), __ATOMIC_RELAXED, __HIP_MEMORY_SCOPE_AGENT) < nwork) {
                for (int qq = lq; qq < 2 && j < 0; ++qq) {
                    if (__hip_atomic_load(p.qhead() + qq * 16, __ATOMIC_RELAXED, __HIP_MEMORY_SCOPE_AGENT) >= 6144) continue;
                    const int c = __hip_atomic_fetch_add(p.qhead() + qq * 16, 4, __ATOMIC_RELAXED, __HIP_MEMORY_SCOPE_AGENT);
                    if (c < 6144) j = qq * 6144 + c; } }
            jb[0] = j; }
        __syncthreads();
        const int j = jb[0];
        if (j < 0) break;
        conv_pipe<false>(p, wg, wu, wd, 4, [&](int k) { return moe_job_tile(j + k); }, T, tid);
    }
    __syncthreads();
}
__device__ __forceinline__ void bg_drain(const Q& p, LAS unsigned char* lds, int lq, int bid, int nb) {
    const int tid = lid();
    LAS float* T = (LAS float*)lds;
    const float* wg = p.moe_w_gate(); const float* wu = p.moe_w_up(); const float* wd = p.moe_w_down();
    int head = __builtin_amdgcn_readfirstlane(__hip_atomic_load(p.qhead() + lq * 16, __ATOMIC_RELAXED, __HIP_MEMORY_SCOPE_AGENT));
    if (head > 6144) head = 6144;
    __syncthreads();
    conv_pipe<false>(p, wg, wu, wd, (6144 - head - bid + nb - 1) / nb, [&](int k) { return moe_job_tile(lq * 6144 + head + bid + k * nb); }, T, tid);
}
__device__ __forceinline__ void worker_done(const Q& p, int ph) {
    __syncthreads();
    if (lid() == 0) __hip_atomic_fetch_add(p.pdone(ph), 1, __ATOMIC_RELAXED, __HIP_MEMORY_SCOPE_AGENT);
}

__device__ __forceinline__ int slot_offsets(const int* cnt, int lane, int& total) {
    int v = lane < 32 ? ((cnt[(lane & 31) * CNT_STRIDE] + 255) & ~255) : 0;
    int inc = v;
#pragma unroll
    for (int o = 1; o < 32; o <<= 1) { const int t = bperm_i(inc, lane - o); if ((lane & 31) >= o) inc += t; }
    total = bperm_i(inc, 31);
    return inc - v;
}

__device__ __forceinline__ f32x4v bf4_to_f32(const uint2 a) { f32x4v r; r[0] = __uint_as_float(a.x << 16); r[1] = __uint_as_float(a.x & 0xffff0000u); r[2] = __uint_as_float(a.y << 16); r[3] = __uint_as_float(a.y & 0xffff0000u); return r; }
struct RowMeta { int e0, e1, p0, p1; float w0, w1; };
__device__ __forceinline__ void ph_rows_norm1(const Q& p, int lc  , int ln  , const float* src_lat, const float* src_ctx, int bid, int nb, bool srcbf = false  ) {
    const int tid = lid(), lane = tid & 63, gw = __builtin_amdgcn_readfirstlane(bid * 8 + (tid >> 6)), nw = nb * 8;
    int offs = 0, total = 0;
    if (lc >= 0) offs = slot_offsets(p.cnt() + lc * 32 * CNT_STRIDE, lane, total);
    const bool skipctx = (ln < 0) || (lc == 1);
    const int* tke = p.tok_e(); const int* tkp = p.tok_pos(); const float* tkw = p.tok_w();
    auto active = [&](int R) { return R < NR && !(skipctx && (R % TPB) >= SEQ); };
    auto xoff_of = [&](int R) { const int b = R / TPB, t = R % TPB; return t < SEQ ? ((size_t)b * SEQ + t) * D_ : ((size_t)b * CTXL + (t - SEQ)) * D_; };
    auto load_row = [&](int R, f32x4v (&xv)[8], RowMeta& m) {
        if (srcbf) { const bf16_t* sb = p.x1b() + xoff_of(R);
#pragma unroll
            for (int i = 0; i < 8; ++i) { const uint2 r_ = *(const uint2*)(sb + (i * 64 + lane) * 4); xv[i][0] = __uint_as_float(r_.x); xv[i][1] = __uint_as_float(r_.y); } }
        else { const float* src = ((R % TPB) < SEQ ? src_lat : src_ctx) + xoff_of(R);
#pragma unroll
            for (int i = 0; i < 8; ++i) xv[i] = *(const f32x4v*)(src + (i * 64 + lane) * 4); }
        if (lc >= 0) { m.e0 = tke[R * 2]; m.e1 = tke[R * 2 + 1]; m.p0 = tkp[R * 2]; m.p1 = tkp[R * 2 + 1]; m.w0 = tkw[R * 2]; m.w1 = tkw[R * 2 + 1]; }
    };
    int R = gw; f32x4v xv[8]; RowMeta mt{}; bool hv = active(R);
    if (hv) load_row(R, xv, mt);
    for (; R < NR; R += nw) {
        const int Rn = R + nw; f32x4v xn[8]; RowMeta mn{}; const bool hn = active(Rn);
        if (hn) load_row(Rn, xn, mn);
        if (hv) {
            if (srcbf) {
#pragma unroll
                for (int i = 0; i < 8; ++i) { uint2 r_; r_.x = __float_as_uint(xv[i][0]); r_.y = __float_as_uint(xv[i][1]); xv[i] = bf4_to_f32(r_); } }
            const int b = R / TPB, t = R % TPB; const bool lat = t < SEQ; const size_t xoff = xoff_of(R);
            if (lc >= 0) {
                const int s0 = bperm_i(offs, mt.e0) + mt.p0, s1 = bperm_i(offs, mt.e1) + mt.p1;
                const float w0 = mt.w0, w1 = mt.w1;
                const float* g2 = p.mod() + ((size_t)(lc * 5 + (lat ? b : 4))) * 6 * D_ + 5 * D_;
                const bf16_t* y0 = p.yslot() + (size_t)s0 * D_; const bf16_t* y1 = p.yslot() + (size_t)s1 * D_;
                float* dst = p.xw + xoff; bf16_t* dstb = p.x1b() + xoff;
                uint2 ya_[8], yb_[8];
                const bf16_t* dl = p.dbuf() + (size_t)R * D_;
#pragma unroll
                for (int i = 0; i < 8; ++i) { const int k = (i * 64 + lane) * 4; ya_[i] = *(const uint2*)(y0 + k); yb_[i] = *(const uint2*)(y1 + k); xv[i] = xv[i] + bf4_to_f32(*(const uint2*)(dl + k)); }
#pragma unroll
                for (int i = 0; i < 8; ++i) { const int k = (i * 64 + lane) * 4;
                    const uint2 a = ya_[i], c = yb_[i]; const f32x4v gv = *(const f32x4v*)(g2 + k);
                    f32x4v ya, yb;
                    ya[0] = __uint_as_float(a.x << 16); ya[1] = __uint_as_float(a.x & 0xffff0000u); ya[2] = __uint_as_float(a.y << 16); ya[3] = __uint_as_float(a.y & 0xffff0000u);
                    yb[0] = __uint_as_float(c.x << 16); yb[1] = __uint_as_float(c.x & 0xffff0000u); yb[2] = __uint_as_float(c.y << 16); yb[3] = __uint_as_float(c.y & 0xffff0000u);
                    xv[i] = xv[i] + gv * (ya * w0 + yb * w1);
                    if (lc == 1) __builtin_nontemporal_store(xv[i], (f32x4v*)(dst + k));
                    else if (lat) { uint2 w_; w_.x = pg8::cvt_pk_bf16(xv[i][0], xv[i][1]); w_.y = pg8::cvt_pk_bf16(xv[i][2], xv[i][3]); *(uint2*)(dstb + k) = w_; } }
            }
            if (ln >= 0) {
                float ss = 0.f;
#pragma unroll
                for (int i = 0; i < 8; ++i) ss += xv[i][0] * xv[i][0] + xv[i][1] * xv[i][1] + xv[i][2] * xv[i][2] + xv[i][3] * xv[i][3];
                ss = wave_sum(ss);
                const float rstd = rsqrtf(ss / D_ + EPS);
                const float* md = p.mod() + ((size_t)(ln * 5 + (lat ? b : 4))) * 6 * D_;
                const float* g = p.norm1_g() + ln * D_;
#pragma unroll
                for (int i = 0; i < 8; ++i) { const int k = (i * 64 + lane) * 4;
                    const f32x4v gv = *(const f32x4v*)(g + k), sc = *(const f32x4v*)(md + D_ + k), sh = *(const f32x4v*)(md + k);
                    const f32x4v h = xv[i] * rstd * gv * (sc + 1.0f) + sh;
                    uint2 w; w.x = pg8::cvt_pk_bf16(h[0], h[1]); w.y = pg8::cvt_pk_bf16(h[2], h[3]);
                    *(uint2*)(p.hbuf() + (size_t)R * D_ + k) = w; }
            }
        }
#pragma unroll
        for (int i = 0; i < 8; ++i) xv[i] = xn[i];
        mt = mn; hv = hn;
    }
}

__device__ __forceinline__ void up8(const uint4 w, float (&v)[8]) {
    const unsigned u[4] = {w.x, w.y, w.z, w.w};
#pragma unroll
    for (int i = 0; i < 4; ++i) { v[2 * i] = __uint_as_float(u[i] << 16); v[2 * i + 1] = __uint_as_float(u[i] & 0xffff0000u); }
}
template <int SEGL> __device__ __forceinline__ void seg_nr(float (&v)[8], const float (&g)[8], bool rope, const f32x4v c0, const f32x4v c1, const f32x4v s0, const f32x4v s1, int lane, float scale) {
    float ss = 0.f;
#pragma unroll
    for (int i = 0; i < 8; ++i) ss += v[i] * v[i];
    ss = grp_sum<SEGL>(ss);
    const float r = rsqrtf(ss / (float)(SEGL * 8) + EPS);
#pragma unroll
    for (int i = 0; i < 8; ++i) v[i] = v[i] * r * g[i];
    if (rope) {
        const float c[8] = {c0[0], c0[1], c0[2], c0[3], c1[0], c1[1], c1[2], c1[3]}, s[8] = {s0[0], s0[1], s0[2], s0[3], s1[0], s1[1], s1[2], s1[3]};
        const bool upper = (lane & (SEGL / 2)) != 0;
#pragma unroll
        for (int i = 0; i < 8; ++i) { const float pr = shx(v[i], SEGL / 2); v[i] = upper ? pr * s[i] + v[i] * c[i] : v[i] * c[i] - pr * s[i]; }
    }
#pragma unroll
    for (int i = 0; i < 8; ++i) v[i] *= scale;
}
struct P1Row { uint4 z[8]; f32x4v cs[8]; };
__device__ __forceinline__ void ph_post1(const Q& p, int l, int bid, int nb) {
    const int tid = lid(), lane = tid & 63, gw = __builtin_amdgcn_readfirstlane(bid * 8 + (tid >> 6)), nw = nb * 8;
    const float scaleA = 0.125f * LOG2E, scaleB = 0.08838834764831845f * LOG2E;
    float gAq[8], gAk[8], gBq[8], gBk[8], gCq[8], gCkv[8], gCkr[8];
    ld8g(p.a_qn() + l * 64 + (lane & 7) * 8, gAq); ld8g(p.a_kn() + l * 64 + (lane & 7) * 8, gAk);
    ld8g(p.b_qn() + l * 128 + (lane & 15) * 8, gBq); ld8g(p.b_kn() + l * 128 + (lane & 15) * 8, gBk);
    ld8g(p.c_qa_norm() + l * 512 + lane * 8, gCq); ld8g(p.c_kva_norm() + l * 256 + (lane & 31) * 8, gCkv); ld8g(p.c_kn() + l * 192 + 128 + (lane & 7) * 8, gCkr);
    const bf16_t* zb = p.z(); const float* cA = p.cosA(); const float* sA = p.sinA(); const float* cB = p.cosB(); const float* sB = p.sinB();
    auto load_row = [&](int R, P1Row& d) {
        const int t = R % TPB; const int tt = t < SEQ ? t : 0;
        const bf16_t* zr = zb + (size_t)R * ZLD;
        d.z[0] = *(const uint4*)(zr + lane * 8); d.z[1] = *(const uint4*)(zr + 512 + lane * 8);
        d.z[2] = *(const uint4*)(zr + 1536 + lane * 8); d.z[3] = *(const uint4*)(zr + 2048 + lane * 8);
        d.z[4] = *(const uint4*)(zr + 2560 + (lane & 31) * 8); d.z[5] = *(const uint4*)(zr + 3072 + lane * 8);
        d.z[6] = *(const uint4*)(zr + 3584 + (lane & 31) * 8); d.z[7] = *(const uint4*)(zr + 3840 + (lane & 7) * 8);
        const int jA = tt * 32 + (lane & 3) * 8, jB = tt * 64 + (lane & 7) * 8;
        d.cs[0] = *(const f32x4v*)(cA + jA); d.cs[1] = *(const f32x4v*)(cA + jA + 4); d.cs[2] = *(const f32x4v*)(sA + jA); d.cs[3] = *(const f32x4v*)(sA + jA + 4);
        d.cs[4] = *(const f32x4v*)(cB + jB); d.cs[5] = *(const f32x4v*)(cB + jB + 4); d.cs[6] = *(const f32x4v*)(sB + jB); d.cs[7] = *(const f32x4v*)(sB + jB + 4);
    };
    int R = gw; P1Row cur; if (R < NR) load_row(R, cur);
    for (; R < NR; R += nw) {
        const int Rn = R + nw; P1Row nxt; if (Rn < NR) load_row(Rn, nxt); else nxt = cur;
        const bool lat = (R % TPB) < SEQ;
        float v[8];
        up8(cur.z[0], v); seg_nr<8>(v, gAq, lat, cur.cs[0], cur.cs[1], cur.cs[2], cur.cs[3], lane, scaleA); st8bf(p.QA() + (size_t)R * 512 + lane * 8, v);
        up8(cur.z[1], v); seg_nr<8>(v, gAk, lat, cur.cs[0], cur.cs[1], cur.cs[2], cur.cs[3], lane, 1.0f); st8bf(p.KA() + (size_t)R * 512 + lane * 8, v);
        up8(cur.z[2], v); seg_nr<16>(v, gBq, lat, cur.cs[4], cur.cs[5], cur.cs[6], cur.cs[7], lane, scaleB); st8bf(p.QB() + (size_t)R * 1024 + lane * 8, v);
        up8(cur.z[3], v); seg_nr<16>(v, gBq, lat, cur.cs[4], cur.cs[5], cur.cs[6], cur.cs[7], lane, scaleB); st8bf(p.QB() + (size_t)R * 1024 + 512 + lane * 8, v);
        up8(cur.z[4], v); seg_nr<16>(v, gBk, lat, cur.cs[4], cur.cs[5], cur.cs[6], cur.cs[7], lane, 1.0f); if (lane < 32) st8bf(p.KB() + (size_t)R * 256 + lane * 8, v);
        up8(cur.z[5], v); seg_nr<64>(v, gCq, false, cur.cs[0], cur.cs[1], cur.cs[2], cur.cs[3], lane, 1.0f); st8bf(p.cqn() + (size_t)R * 512 + lane * 8, v);
        up8(cur.z[6], v); seg_nr<32>(v, gCkv, false, cur.cs[0], cur.cs[1], cur.cs[2], cur.cs[3], lane, 1.0f); if (lane < 32) st8bf(p.ckvn() + (size_t)R * 256 + lane * 8, v);
        up8(cur.z[7], v); seg_nr<8>(v, gCkr, lat, cur.cs[0], cur.cs[1], cur.cs[2], cur.cs[3], lane, 1.0f); if (lane < 32) st8bf(p.KC() + (size_t)R * 768 + (lane >> 3) * 192 + 128 + (lane & 7) * 8, v);
        cur = nxt;
    }
}
struct P2Row { uint4 qn, kn, qr, kr; f32x4v cs[4]; };
__device__ __forceinline__ void ph_post2(const Q& p, int l, int bid, int nb) {
    const int tid = lid(), lane = tid & 63, gw = __builtin_amdgcn_readfirstlane(bid * 8 + (tid >> 6)), nw = nb * 8;
    const float scaleC = 0.07216878364870323f * LOG2E;
    const int h4 = lane >> 4, d16 = (lane & 15) * 8, h8 = (lane & 31) >> 3, d8 = (lane & 7) * 8;
    float gQn[8], gKn[8], gQr[8];
    ld8g(p.c_qn() + l * 192 + d16, gQn); ld8g(p.c_kn() + l * 192 + d16, gKn); ld8g(p.c_qn() + l * 192 + 128 + d8, gQr);
    const bf16_t* q2 = p.q2(); const bf16_t* kv2 = p.kv2(); const bf16_t* krp = p.krope(); const float* cA = p.cosA(); const float* sA = p.sinA();
    auto load_row = [&](int R, P2Row& d) {
        const int t = R % TPB; const int tt = t < SEQ ? t : 0;
        d.qn = *(const uint4*)(q2 + (size_t)R * 768 + h4 * 192 + d16); d.kn = *(const uint4*)(kv2 + (size_t)R * 1024 + h4 * 256 + d16);
        d.qr = *(const uint4*)(q2 + (size_t)R * 768 + h8 * 192 + 128 + d8); d.kr = *(const uint4*)(krp + (size_t)R * 64 + d8);
        const int jA = tt * 32 + (lane & 3) * 8;
        d.cs[0] = *(const f32x4v*)(cA + jA); d.cs[1] = *(const f32x4v*)(cA + jA + 4); d.cs[2] = *(const f32x4v*)(sA + jA); d.cs[3] = *(const f32x4v*)(sA + jA + 4);
    };
    int R = gw; P2Row cur; if (R < NR) load_row(R, cur);
    for (; R < NR; R += nw) {
        const int Rn = R + nw; P2Row nxt; if (Rn < NR) load_row(Rn, nxt); else nxt = cur;
        const bool lat = (R % TPB) < SEQ;
        float v[8];
        up8(cur.qn, v); seg_nr<16>(v, gQn, false, cur.cs[0], cur.cs[1], cur.cs[2], cur.cs[3], lane, scaleC); st8bf(p.QC() + (size_t)R * 768 + h4 * 192 + d16, v);
        up8(cur.kn, v); seg_nr<16>(v, gKn, false, cur.cs[0], cur.cs[1], cur.cs[2], cur.cs[3], lane, 1.0f); st8bf(p.KC() + (size_t)R * 768 + h4 * 192 + d16, v);
        up8(cur.qr, v); seg_nr<8>(v, gQr, lat, cur.cs[0], cur.cs[1], cur.cs[2], cur.cs[3], lane, scaleC);
        if (lane < 32) { st8bf(p.QC() + (size_t)R * 768 + h8 * 192 + 128 + d8, v); *(uint4*)(p.KC() + (size_t)R * 768 + h8 * 192 + 128 + d8) = cur.kr; }
        cur = nxt;
    }
}

template <int DQK> __device__ __forceinline__ LAS float* att_scratch(LAS unsigned char* lds, int wid) { return (LAS float*)(lds + 2 * att::SHM_V + 2 * 64 * (2 * DQK + 16)) + wid * 64; }
__device__ __forceinline__ void att_rli(LAS float* li_l, float l_reg, int r32, int hi, float (&rli)[16]) {
    if (hi == 0) li_l[r32] = l_reg;
    asm volatile("s_waitcnt lgkmcnt(0)" ::: "memory");
#pragma unroll
    for (int r = 0; r < 16; ++r) rli[r] = __builtin_amdgcn_rcpf(li_l[att::crow(r, hi)]);
}
__device__ __forceinline__ void att_store(bf16_t* Ob  , const att::f32x16 (&o)[4], const float (&rli)[16], int r32, int hi) {
#pragma unroll
    for (int r = 0; r < 16; ++r) { bf16_t* rp = Ob + (size_t)att::crow(r, hi) * D_ + r32;
#pragma unroll
        for (int d0 = 0; d0 < 4; ++d0) rp[d0 * 32] = f2bf(o[d0][r] * rli[r]); }
}
__device__ __forceinline__ void unit_A(const Q& p, int l, LAS unsigned char* lds, int b, int h, int qrow0, int nt, int s0, float lam, float lam_init, int bid) {
    const int rot = nt >= 36 ? ((qrow0 >> 8) * 9 / 2) * 1 : 0;
    const int tid = lid(), wid = __builtin_amdgcn_readfirstlane(tid >> 6), lane = tid & 63, r32 = lane & 31, hi = lane >> 5;
    const size_t rb = (size_t)b * TPB;
    att::f32x16 o[4]; float m_reg, l_reg; float rli[16];
    float* scr = p.oscr() + (size_t)bid * 256 * 128 + (size_t)(wid * 32) * 128 + (4 * hi * 128 + r32);
    LAS float* li_l = att_scratch<64>(lds, wid);
    __syncthreads();
    att::attn_body<64, false, 2, 0>(lds, p.QA() + (rb + qrow0) * 512 + h * 128, 512, p.KA() + rb * 512 + h * 128, 512, p.z() + rb * ZLD + 1024 + h * 128, ZLD, nt, nt, s0, 0, 0, rot, o, m_reg, l_reg);
    att_rli(li_l, l_reg, r32, hi, rli);
#pragma unroll
    for (int r = 0; r < 16; ++r)
#pragma unroll
        for (int d0 = 0; d0 < 4; ++d0) scr[((r & 3) + 8 * (r >> 2)) * 128 + d0 * 32] = o[d0][r] * rli[r];
    __syncthreads();
    att::attn_body<64, false, 2, 0>(lds, p.QA() + (rb + qrow0) * 512 + h * 128 + 64, 512, p.KA() + rb * 512 + h * 128 + 64, 512, p.z() + rb * ZLD + 1024 + h * 128, ZLD, nt, nt, s0, 0, 0, rot, o, m_reg, l_reg);
    att_rli(li_l, l_reg, r32, hi, rli);
    asm volatile("" : "+v"(scr));
    float ss[16];
#pragma unroll
    for (int r = 0; r < 16; ++r) { ss[r] = 0.f;
#pragma unroll
        for (int d0 = 0; d0 < 4; ++d0) { const float v = scr[((r & 3) + 8 * (r >> 2)) * 128 + d0 * 32] - lam * (o[d0][r] * rli[r]); o[d0][r] = v; ss[r] += v * v; } }
#pragma unroll
    for (int r = 0; r < 16; ++r) { float s = ss[r];
#pragma unroll
        for (int of = 16; of >= 1; of >>= 1) s += shx(s, of);
        rli[r] = rsqrtf(s / 128.0f + EPS) * (1.0f - lam_init); }
    const float* sg = p.a_subln() + l * 128;
    float sgv[4];
#pragma unroll
    for (int d0 = 0; d0 < 4; ++d0) sgv[d0] = sg[d0 * 32 + r32];
#pragma unroll
    for (int d0 = 0; d0 < 4; ++d0)
#pragma unroll
        for (int r = 0; r < 16; ++r) o[d0][r] *= sgv[d0];
    att_store(p.mix() + (rb + qrow0 + wid * 32) * D_ + h * 128, o, rli, r32, hi);
}
__device__ __forceinline__ void unit_B(const Q& p, int l, LAS unsigned char* lds, int b, int h, int qrow0, bool ctxq) {
    const int tid = lid(), wid = __builtin_amdgcn_readfirstlane(tid >> 6), lane = tid & 63, r32 = lane & 31, hi = lane >> 5;
    const size_t rb = (size_t)b * TPB; const int kvh = h >> 2;
    att::f32x16 o[4]; float m_reg, l_reg; float rli[16];
    int nt = 4, s1 = 0;
    if (!ctxq) { const int kl0 = qrow0 >= 128 ? qrow0 - 128 : 0, kl1 = qrow0 + 384 <= SEQ ? qrow0 + 384 : SEQ; nt = 4 + (kl1 - kl0) / 64; s1 = kl0; }
    __syncthreads();
    att::attn_body_np<128, true, 2>(lds, p.QB() + (rb + qrow0) * 1024 + h * 128, 1024, p.KB() + rb * 256 + kvh * 128, 256, p.z() + rb * ZLD + 2816 + kvh * 128, ZLD, nt, 4, SEQ, s1, qrow0, 0, o, m_reg, l_reg);
    l_reg += __builtin_amdgcn_exp2f(p.b_sink()[l * 8 + h] * LOG2E - m_reg);
    att_rli(att_scratch<128>(lds, wid), l_reg, r32, hi, rli);
    att_store(p.mix() + (rb + qrow0 + wid * 32) * D_ + 512 + h * 128, o, rli, r32, hi);
}
__device__ __forceinline__ void unit_C(const Q& p, int l, LAS unsigned char* lds, int b, int h, int qrow0, int nt, int s0) {
    const int tid = lid(), wid = __builtin_amdgcn_readfirstlane(tid >> 6), lane = tid & 63, r32 = lane & 31, hi = lane >> 5;
    const size_t rb = (size_t)b * TPB;
    att::f32x16 o[4]; float m_reg, l_reg; float rli[16];
    __syncthreads();
    att::attn_body_np<192, false, 2, true>(lds, p.q2() + (rb + qrow0) * 768 + h * 192, 768, p.KC() + rb * 768 + h * 192, 768, p.kv2() + rb * 1024 + h * 256 + 128, 1024, nt, nt, s0, 0, qrow0, nt >= 36 ? ((qrow0 >> 8) * 9 / 2) : 0, o, m_reg, l_reg,
                                           p.c_qn() + l * 192, p.cosA(), p.sinA(), qrow0 < SEQ, 0.07216878364870323f * LOG2E);
    att_rli(att_scratch<192>(lds, wid), l_reg, r32, hi, rli);
    att_store(p.mix() + (rb + qrow0 + wid * 32) * D_ + 1536 + h * 128, o, rli, r32, hi);
}
__device__ __forceinline__ void ph_attn(const Q& p, int l, LAS unsigned char* lds, int bid, int nb) {
    const int lane = lid() & 63;
    const float* lv = p.a_lambda() + l * 256;
    const float s01 = wave_sum(lv[lane] * lv[64 + lane]), s23 = wave_sum(lv[128 + lane] * lv[192 + lane]);
    const float lam_init = 0.8f - 0.6f * expf(-0.3f * (float)l), lam = expf(s01) - expf(s23) + lam_init;
    for (int i = bid; i < 256; i += nb) {
        const int xcd = i & 7;
        if (i < 128) { const int slot = i >> 3, bh = xcd * 2 + (slot >> 3); unit_A(p, l, lds, bh >> 2, bh & 3, (slot & 7) * 256, 36, 0, lam, lam_init, bid); }
        if (i >= 128) { const int slot = (i - 128) >> 3, bh = xcd * 2 + (slot >> 3); unit_C(p, l, lds, bh >> 2, bh & 3, (slot & 7) * 256, 36, 0); }
        if (i >= 128) {
#pragma unroll 1
            for (int hb = 0; hb < 2; ++hb) { const int slot = ((i - 128) >> 3) * 2 + hb; unit_B(p, l, lds, xcd >> 1, (xcd & 1) * 4 + (slot >> 3), (slot & 7) * 256, false); } }
        if (l == 0 && i < 64) { const int k = i;
            if (k < 16) unit_A(p, l, lds, k >> 2, k & 3, SEQ, 4, SEQ, lam, lam_init, bid);
            else if (k < 32) unit_C(p, l, lds, (k - 16) >> 2, (k - 16) & 3, SEQ, 4, SEQ);
            else unit_B(p, l, lds, (k - 32) >> 3, (k - 32) & 7, SEQ, true); }
    }
}

__device__ __forceinline__ void route_row(const Q& p, float logit  , int R, int lane, LAS int* lcnt) {
    const int e = lane >> 1;
    const float sg = 1.0f / (1.0f + expf(-logit));
    const float sel = sg + p.router_bias()[e];
    float v1 = sel; int i1 = e;
#pragma unroll
    for (int o = 2; o <= 8; o <<= 1) { const float ov = shx(v1, o); const int oi = bperm_i(i1, lane ^ o); const bool tk = (ov > v1) || (ov == v1 && oi < i1); v1 = tk ? ov : v1; i1 = tk ? oi : i1; }
    float v2 = (e == i1) ? -3e38f : sel; int i2 = (e == i1) ? 64 : e;
#pragma unroll
    for (int o = 2; o <= 8; o <<= 1) { const float ov = shx(v2, o); const int oi = bperm_i(i2, lane ^ o); const bool tk = (ov > v2) || (ov == v2 && oi < i2); v2 = tk ? ov : v2; i2 = tk ? oi : i2; }
    float gs = v1 + v2; int gb = e >> 3;
#pragma unroll
    for (int o = 16; o <= 32; o <<= 1) { const float ov = shx(gs, o); const int og = bperm_i(gb, lane ^ o); const bool tk = (ov > gs) || (ov == gs && og < gb); gs = tk ? ov : gs; gb = tk ? og : gb; }
    const int e0 = bperm_i(i1, gb * 16), e1 = bperm_i(i2, gb * 16);
    const float w0 = __int_as_float(bperm_i(__float_as_int(sg), e0 * 2)), w1 = __int_as_float(bperm_i(__float_as_int(sg), e1 * 2));
    if (lane == 0) {
        const float inv = 1.0f / (w0 + w1);
        p.tok_e()[R * 2] = e0; p.tok_e()[R * 2 + 1] = e1;
        p.tok_w()[R * 2] = w0 * inv; p.tok_w()[R * 2 + 1] = w1 * inv;
        p.tok_pos()[R * 2] = __hip_atomic_fetch_add(lcnt + e0, 1, __ATOMIC_RELAXED, __HIP_MEMORY_SCOPE_WORKGROUP);
        p.tok_pos()[R * 2 + 1] = __hip_atomic_fetch_add(lcnt + e1, 1, __ATOMIC_RELAXED, __HIP_MEMORY_SCOPE_WORKGROUP);
    }
}
__device__ __forceinline__ void ph_norm2(const Q& p, int l, LAS unsigned char* lds, int bid, int nb) {
    const int tid = lid(), lane = tid & 63, wid = __builtin_amdgcn_readfirstlane(tid >> 6), r32 = lane & 31, hh = lane >> 5;
    LAS float* red = (LAS float*)lds;
    LAS float* rstd_s = red + 8 * 32 * 32;
    LAS int* lcnt = (LAS int*)(rstd_s + 32);
    LAS float* m1s = rstd_s + 64;
    LAS float* shs = m1s + 2048;
    LAS float* xt = shs + 2048 + wid * (32 * 68);
    if (tid < 32) lcnt[tid] = 0;
    __syncthreads();
    const int nrows = l == 0 ? NR : NBATCH * SEQ, nsteps = nrows / 32;
    const float* g = p.norm2_g() + l * D_;
    att::bf16x8 bhi[16];
    {   const bf16_t* bh = p.rwT() + (size_t)r32 * 2048 + wid * 256 + hh * 8;
#pragma unroll
        for (int s_ = 0; s_ < 16; ++s_) bhi[s_] = *reinterpret_cast<const att::bf16x8*>(bh + s_ * 16); }
    for (int step = bid; step < nsteps; step += nb) {
        const int ri0 = step * 32, R0 = l == 0 ? ri0 : (ri0 >> 11) * TPB + (ri0 & 2047);
        const int b = R0 / TPB, t0 = R0 % TPB; const bool lat = t0 < SEQ;
        const float* xs = (lat ? (l == 0 ? p.x() : p.xw) + ((size_t)b * SEQ + t0) * D_ : (l == 0 ? p.ctx() : p.xc()) + ((size_t)b * CTXL + (t0 - SEQ)) * D_);
        const bf16_t* xsb = p.x1b() + ((size_t)b * SEQ + t0) * D_;
#define N2_LDX(dst, off) do { if (l == 1) { const uint2 r_ = *(const uint2*)(xsb + (off)); dst[0] = __uint_as_float(r_.x); dst[1] = __uint_as_float(r_.y); } else dst = *(const f32x4v*)(xs + (off)); } while (0)
#define N2_CVX(v) (l == 1 ? bf4_to_f32(make_uint2(__float_as_uint(v[0]), __float_as_uint(v[1]))) : v)
        const bf16_t* ds = p.dbuf() + (size_t)R0 * D_;
        const float* md = p.mod() + ((size_t)(l * 5 + (lat ? b : 4))) * 6 * D_;
        {   const int k = tid * 4; const f32x4v gv = *(const f32x4v*)(g + k), sc = *(const f32x4v*)(md + 4 * D_ + k), sh = *(const f32x4v*)(md + 3 * D_ + k);
            *(LAS f32x4v*)(m1s + k) = gv * (sc + 1.0f); *(LAS f32x4v*)(shs + k) = sh; }
        f32x4v xa[8], xb[8];
#pragma unroll
        for (int i = 0; i < 8; ++i) { const int k = (i * 64 + lane) * 4; N2_LDX(xa[i], (size_t)(wid * 4) * D_ + k); N2_LDX(xb[i], (size_t)(wid * 4 + 1) * D_ + k); }
        __builtin_amdgcn_sched_barrier(0);
#pragma unroll
        for (int hf = 0; hf < 2; ++hf) {
#pragma unroll
            for (int i = hf * 4; i < hf * 4 + 4; ++i) { const int k = (i * 64 + lane) * 4;
                const uint2 da_ = *(const uint2*)(ds + (size_t)(wid * 4) * D_ + k), db_ = *(const uint2*)(ds + (size_t)(wid * 4 + 1) * D_ + k);
                xa[i] = N2_CVX(xa[i]) + bf4_to_f32(da_); xb[i] = N2_CVX(xb[i]) + bf4_to_f32(db_); }
            __builtin_amdgcn_sched_barrier(0); }
        __syncthreads();
#pragma unroll 1
        for (int rp = 0; rp < 2; ++rp) {
            const int ra = wid * 4 + rp * 2; float sa = 0.f, sb = 0.f;
#pragma unroll
            for (int i = 0; i < 8; ++i) { sa += xa[i][0] * xa[i][0] + xa[i][1] * xa[i][1] + xa[i][2] * xa[i][2] + xa[i][3] * xa[i][3];
                                          sb += xb[i][0] * xb[i][0] + xb[i][1] * xb[i][1] + xb[i][2] * xb[i][2] + xb[i][3] * xb[i][3]; }
            sa = wave_sum(sa); sb = wave_sum(sb);
            const float rsa = rsqrtf(sa / D_ + EPS), rsb = rsqrtf(sb / D_ + EPS);
            if (lane == 0) { rstd_s[ra] = rsa; rstd_s[ra + 1] = rsb; }
#pragma unroll
            for (int i = 0; i < 8; ++i) { const int k = (i * 64 + lane) * 4;
                const f32x4v m1 = *(const LAS f32x4v*)(m1s + k), sh = *(const LAS f32x4v*)(shs + k);
                const f32x4v ha = xa[i] * rsa * m1 + sh, hb = xb[i] * rsb * m1 + sh;
                uint2 w; w.x = pg8::cvt_pk_bf16(ha[0], ha[1]); w.y = pg8::cvt_pk_bf16(ha[2], ha[3]);
                *(uint2*)(p.hbuf() + (size_t)(R0 + ra) * D_ + k) = w;
                w.x = pg8::cvt_pk_bf16(hb[0], hb[1]); w.y = pg8::cvt_pk_bf16(hb[2], hb[3]);
                *(uint2*)(p.hbuf() + (size_t)(R0 + ra + 1) * D_ + k) = w; }
            if (rp == 0) {
#pragma unroll
                for (int i = 0; i < 8; ++i) { const int k = (i * 64 + lane) * 4; N2_LDX(xa[i], (size_t)(wid * 4 + 2) * D_ + k); N2_LDX(xb[i], (size_t)(wid * 4 + 3) * D_ + k); }
                __builtin_amdgcn_sched_barrier(0);
#pragma unroll
                for (int hf = 0; hf < 2; ++hf) {
#pragma unroll
                    for (int i = hf * 4; i < hf * 4 + 4; ++i) { const int k = (i * 64 + lane) * 4;
                        const uint2 da_ = *(const uint2*)(ds + (size_t)(wid * 4 + 2) * D_ + k), db_ = *(const uint2*)(ds + (size_t)(wid * 4 + 3) * D_ + k);
                        xa[i] = N2_CVX(xa[i]) + bf4_to_f32(da_); xb[i] = N2_CVX(xb[i]) + bf4_to_f32(db_); }
                    __builtin_amdgcn_sched_barrier(0); } }
        }
        __syncthreads();
        {   const float rs = rstd_s[r32];
            att::f32x16 acc = att::f32x16{};
            const LAS float* m1k = m1s + wid * 256 + hh * 8; const LAS float* shk = shs + wid * 256 + hh * 8;
#pragma unroll
            for (int sc4 = 0; sc4 < 4; ++sc4) {
                f32x4v xl[8];
#pragma unroll
                for (int i = 0; i < 8; ++i) { const size_t o_ = (size_t)(i * 4 + (lane >> 4)) * D_ + wid * 256 + sc4 * 64 + (lane & 15) * 4; const uint2 dd_ = *(const uint2*)(ds + o_); if (l == 1) { const uint2 xr_ = *(const uint2*)(xsb + o_); xl[i] = bf4_to_f32(xr_) + bf4_to_f32(dd_); } else xl[i] = *(const f32x4v*)(xs + o_) + bf4_to_f32(dd_); }
#pragma unroll
                for (int i = 0; i < 8; ++i) *(LAS f32x4v*)(xt + (i * 4 + (lane >> 4)) * 68 + (lane & 15) * 4) = xl[i];
                asm volatile("s_waitcnt lgkmcnt(0)" ::: "memory");
#pragma unroll
                for (int s4 = 0; s4 < 4; ++s4) { const int s_ = sc4 * 4 + s4;
                    const f32x4v x0 = *(const LAS f32x4v*)(xt + r32 * 68 + s4 * 16 + hh * 8), x1 = *(const LAS f32x4v*)(xt + r32 * 68 + s4 * 16 + hh * 8 + 4);
                    const f32x4v ma = *(const LAS f32x4v*)(m1k + s_ * 16), mb = *(const LAS f32x4v*)(m1k + s_ * 16 + 4), sa4 = *(const LAS f32x4v*)(shk + s_ * 16), sb4 = *(const LAS f32x4v*)(shk + s_ * 16 + 4);
                    const f32x4v h0 = x0 * rs * ma + sa4, h1 = x1 * rs * mb + sb4;
                    const float hv[8] = {h0[0], h0[1], h0[2], h0[3], h1[0], h1[1], h1[2], h1[3]};
                    float lo[8]; unsigned hp[4], lp[4];
#pragma unroll
                    for (int j = 0; j < 4; ++j) { hp[j] = pg8::cvt_pk_bf16(hv[2 * j], hv[2 * j + 1]);
                        lo[2 * j] = hv[2 * j] - __uint_as_float(hp[j] << 16); lo[2 * j + 1] = hv[2 * j + 1] - __uint_as_float(hp[j] & 0xffff0000u); }
#pragma unroll
                    for (int j = 0; j < 4; ++j) lp[j] = pg8::cvt_pk_bf16(lo[2 * j], lo[2 * j + 1]);
                    att::u32x4 hw = {hp[0], hp[1], hp[2], hp[3]}, lw = {lp[0], lp[1], lp[2], lp[3]};
                    const att::bf16x8 ahi = *reinterpret_cast<att::bf16x8*>(&hw), alo = *reinterpret_cast<att::bf16x8*>(&lw);
                    acc = __builtin_amdgcn_mfma_f32_32x32x16_bf16(ahi, bhi[s_], acc, 0, 0, 0);
                    acc = __builtin_amdgcn_mfma_f32_32x32x16_bf16(alo, bhi[s_], acc, 0, 0, 0); }
                asm volatile("s_waitcnt lgkmcnt(0)" ::: "memory");
            }
#pragma unroll
            for (int r = 0; r < 16; ++r) red[(wid * 32 + att::crow(r, hh)) * 32 + r32] = acc[r];
        }
        __syncthreads();
#pragma unroll 1
        for (int rr = 0; rr < 4; ++rr) { const int row = wid * 4 + rr; float lg = 0.f;
#pragma unroll
            for (int w = 0; w < 8; ++w) lg += red[(w * 32 + row) * 32 + (lane >> 1)];
            route_row(p, lg, R0 + row, lane, lcnt); }
        __syncthreads();
    }
    __syncthreads();
    LAS int* gbase = (LAS int*)red;
    if (tid < 32) { const int n = lcnt[tid]; gbase[tid] = n > 0 ? __hip_atomic_fetch_add(p.cnt() + (l * 32 + tid) * CNT_STRIDE, n, __ATOMIC_RELAXED, __HIP_MEMORY_SCOPE_AGENT) : 0; }
    __syncthreads();
    {   int* tkp = p.tok_pos(); const int* tke = p.tok_e(); int* sm = p.smap();
        for (int idx = tid; ; idx += 512) { const int step = bid + (idx >> 5) * nb; if (step >= nsteps) break;
            const int ri = step * 32 + (idx & 31), R = l == 0 ? ri : (ri >> 11) * TPB + (ri & 2047);
            const int e0 = tke[R * 2], e1 = tke[R * 2 + 1], p0 = tkp[R * 2] + gbase[e0], p1 = tkp[R * 2 + 1] + gbase[e1];
            tkp[R * 2] = p0; tkp[R * 2 + 1] = p1; sm[e0 * NR + p0] = R; sm[e1 * NR + p1] = R; } }
}

__device__ __forceinline__ void moe_table(const Q& p, int l, LAS int* tab) {
    const int tid = lid(), lane = tid & 63;
    __syncthreads();
    if (tid < 64) {
        int total; const int offs = slot_offsets(p.cnt() + l * 32 * CNT_STRIDE, lane, total);
        const int nxt = bperm_i(offs, lane + 1);
        const int hi_ = lane < 31 ? nxt : total;
        if (lane < 32) { for (int tl = offs >> 8; tl < (hi_ >> 8); ++tl) { tab[8 + tl] = lane; tab[128 + tl] = tl - (offs >> 8); } tab[272 + lane] = p.cnt()[(l * 32 + lane) * CNT_STRIDE]; }
        if (lane == 0) tab[0] = total >> 8;
    }
    __syncthreads();
}
__device__ __forceinline__ void moe_rows_cache(const Q& p, const LAS int* tab, LAS int* rows, int G, int c) {
    const int tid = lid(); const int* sm = p.smap();
    for (int idx = tid; idx < 1024; idx += 512) { const int i = idx >> 8, r = idx & 255; const long L = (long)i * G + c;
        if (L < (long)tab[0] * 4) { const int tile = (int)(L / 4), e = tab[8 + tile], pos = tab[128 + tile] * 256 + r; rows[idx] = pos < tab[272 + e] ? sm[e * NR + pos] : 0; } }
    __syncthreads();
}

__global__ void __launch_bounds__(512, 2) mega(P p, int ph_lo, int ph_hi) {
    extern __shared__ __attribute__((aligned(16))) unsigned char shm_raw[];
    LAS unsigned char* lds = (LAS unsigned char*)shm_raw;
    const int bid0 = blockIdx.x, nb0 = gridDim.x, tid = threadIdx.x;
    if (tid < 4) ((LAS unsigned*)(lds + LDS_BAR_OFF))[tid] = 0u;
    __syncthreads();
    XcdBarrier bar; bar.bar = p.bar(); bar.x = 0; bar.st = (volatile LAS unsigned*)(lds + LDS_BAR_OFF);
    if (ph_hi - ph_lo > 1) bar = xcd_barrier_post(p.bar(), (volatile LAS unsigned*)(lds + LDS_BAR_OFF));
    LAS int* tab = (LAS int*)(lds + LDS_TAB_OFF);
#define PHASE_BEGIN(id) if ((id) >= ph_lo && (id) < ph_hi) { const int bid = sid(bid0), nb = sid(nb0); Q q; q.xw = sidp(p.xw); q.ws = sidp(p.ws);
#define PHASE_END(id) if ((id) + 1 < ph_hi) { XcdBarrier b2 = bar; b2.x = (unsigned)sid((int)b2.x); xcd_barrier(b2); } }
    PHASE_BEGIN(0) ph_prologue(p, lds, bid, nb);
        if (bid == 0 && tid == 0) { const float** tb = (const float**)(p.ws + WSO_tbl);
            tb[0] = p.x; tb[1] = p.c; tb[2] = p.ctx; tb[3] = p.c_ctx; tb[4] = p.ada_w; tb[5] = p.ada_b; tb[6] = p.norm1_g; tb[7] = p.norm2_g; tb[8] = p.w_in; tb[9] = p.w_out; tb[10] = p.a_qn; tb[11] = p.a_kn; tb[12] = p.a_lambda; tb[13] = p.a_subln; tb[14] = p.b_qn; tb[15] = p.b_kn; tb[16] = p.b_sink; tb[17] = p.c_qa_norm; tb[18] = p.c_kva_norm; tb[19] = p.c_wuq; tb[20] = p.c_wukv; tb[21] = p.c_qn; tb[22] = p.c_kn; tb[23] = p.router_w; tb[24] = p.router_bias; tb[25] = p.moe_w_gate; tb[26] = p.moe_w_up; tb[27] = p.moe_w_down; }
    PHASE_END(0)
    auto layer = [&](const int l) __attribute__((always_inline)) {
        const int pb = 1 + l * 11;
        PHASE_BEGIN(pb + 0) ph_rows_norm1(q, l == 0 ? -1 : 0, l, q.x(), q.ctx(), bid, nb); PHASE_END(pb + 0)
        PHASE_BEGIN(pb + 1) if (bid < NW_IN) { pg8::Gemm g{q.hbuf(), q.winT() + (size_t)l * ZLD * D_, NR, ZLD, D_}; pg8::StaticOrder S; S.init(NR, ZLD, NW_IN, bid);
            EpiStore E{q.z(), ZLD, 0x7fffffff}; pg8::gemm_phase<EpiStore, pg8::StaticOrder>(lds, g, S, E, nullptr); worker_done(q, pb + 1); }
            else bg_window(q, lds, pb + 1, NW_IN, l); PHASE_END(pb + 1)
        PHASE_BEGIN(pb + 2) ph_post1(q, l, bid, nb); PHASE_END(pb + 2)
        PHASE_BEGIN(pb + 3) {
            if (bid < 108) { pg8::Gemm g{q.cqn(), q.wuqT() + (size_t)l * 768 * 512, NR, 768, 512}; pg8::StaticOrder S; S.init(NR, 768, 108, bid);
                EpiStore E{q.q2(), 768, 0x7fffffff}; pg8::gemm_phase<EpiStore, pg8::StaticOrder>(lds, g, S, E, nullptr); }
            else if (bid < 252) { pg8::Gemm g{q.ckvn(), q.wukvT() + (size_t)l * 1024 * 256, NR, 1024, 256}; pg8::StaticOrder S; S.init(NR, 1024, 144, bid - 108);
                EpiKVNorm E{q.kv2(), q.KC(), q.c_kn() + l * 192}; pg8::gemm_phase<EpiKVNorm, pg8::StaticOrder>(lds, g, S, E, nullptr); }
        } PHASE_END(pb + 3)
        PHASE_BEGIN(pb + 5) ph_attn(q, l, lds, bid, nb); PHASE_END(pb + 5)
        PHASE_BEGIN(pb + 6) { const bool win = (l == 0);
            if (!win || bid < NW_OUT) { pg8::Gemm g{q.mix(), q.woutT() + (size_t)l * D_ * D_, NR, D_, D_}; MapOrder S; S.init(l == 0 ? NR : NBATCH * SEQ, D_, win ? NW_OUT : nb, bid); S.skipctx = l;
                EpiOutProj E{q.dbuf(), q.mod() + (size_t)l * 5 * 6 * D_};
                pg8::gemm_phase<EpiOutProj, MapOrder>(lds, g, S, E, nullptr); if (win) worker_done(q, pb + 6); }
            else bg_window(q, lds, pb + 6, NW_OUT, 0); } PHASE_END(pb + 6)
        PHASE_BEGIN(pb + 7) ph_norm2(q, l, lds, bid, nb); bg_drain(q, lds, l, bid, nb); PHASE_END(pb + 7)
        PHASE_BEGIN(pb + 9) { const bool win = (l == 0);
            if (!win || bid < NW_GU) { moe_table(q, l, tab);
                LAS int* rows = (LAS int*)(lds + LDS_ROWS_OFF); moe_rows_cache(q, tab, rows, win ? NW_GU : nb, bid);
                pg8::Gemm g{q.hbuf(), q.guT() + (size_t)l * NEXP * 1024 * D_, NR, NEXP * 1024, D_}; MoeGatherOrder S{tab, 4, win ? NW_GU : nb, bid, rows};
                EpiGateUp E{q.actbuf()}; pg8::gemm_phase<EpiGateUp, MoeGatherOrder>(lds, g, S, E, nullptr); if (win) worker_done(q, pb + 9); }
            else bg_window(q, lds, pb + 9, NW_GU, 1); } PHASE_END(pb + 9)
        PHASE_BEGIN(pb + 10) { moe_table(q, l, tab);
            pg8::Gemm g{q.actbuf(), q.dT() + (size_t)l * NEXP * D_ * DEXP, MAXSLOT, NEXP * D_, DEXP}; MoeOrder S{tab, 8, nb, bid};
            EpiStore E{q.yslot(), D_, 7}; pg8::gemm_phase<EpiStore, MoeOrder>(lds, g, S, E, nullptr); } PHASE_END(pb + 10)
    };
    layer(0);
    layer(1);
    PHASE_BEGIN(23) ph_rows_norm1(q, 1, -1, q.xw, q.xc(), bid, nb, true); PHASE_END(23)
#undef PHASE_BEGIN
#undef PHASE_END
}

static inline size_t al256(size_t v) { return (v + 255) & ~(size_t)255; }

extern "C" void kernel_launch(void* const* d_in, const int* in_sizes, int n_in, void* d_out, int out_size, void* d_ws, size_t ws_size, hipStream_t stream) {
    (void)in_sizes; (void)n_in; (void)out_size;
    P p{};
    const float* const* in = (const float* const*)d_in;
    p.x = in[0]; p.c = in[1]; p.ctx = in[2]; p.c_ctx = in[3]; p.ada_w = in[4]; p.ada_b = in[5]; p.norm1_g = in[6]; p.norm2_g = in[7]; p.w_in = in[8]; p.w_out = in[9];
    p.a_qn = in[10]; p.a_kn = in[11]; p.a_lambda = in[12]; p.a_subln = in[13]; p.b_qn = in[14]; p.b_kn = in[15]; p.b_sink = in[16];
    p.c_qa_norm = in[17]; p.c_kva_norm = in[18]; p.c_wuq = in[19]; p.c_wukv = in[20]; p.c_qn = in[21]; p.c_kn = in[22];
    p.router_w = in[23]; p.router_bias = in[24]; p.moe_w_gate = in[25]; p.moe_w_up = in[26]; p.moe_w_down = in[27];
    p.xw = (float*)d_out; p.ws = (char*)d_ws;
    const size_t o = WS_END2, ctl_bytes = CTL_BYTES;
    static_assert(XCD_BAR_WORDS == 3456, "workspace map assumes 3456 barrier words");
    static int grid = 0;
    if (!grid) {
        if (o > ws_size) { fprintf(stderr, "kernel_launch: workspace too small: need %zu have %zu\n", o, ws_size); grid = -1; return; }
        int dev = 0, cus = 0, per_cu = 0;
        if (hipGetDevice(&dev) != hipSuccess || hipDeviceGetAttribute(&cus, hipDeviceAttributeMultiprocessorCount, dev) != hipSuccess) { grid = -1; return; }
        if (hipFuncSetAttribute((const void*)mega, hipFuncAttributeMaxDynamicSharedMemorySize, LDS_TOTAL) != hipSuccess) { fprintf(stderr, "kernel_launch: hipFuncSetAttribute failed\n"); grid = -1; return; }
        if (hipOccupancyMaxActiveBlocksPerMultiprocessor(&per_cu, (const void*)mega, 512, LDS_TOTAL) != hipSuccess || per_cu < 1) { fprintf(stderr, "kernel_launch: occupancy query says %d\n", per_cu); grid = -1; return; }
        if (cus < 256) { fprintf(stderr, "kernel_launch: built for a 256-CU device (MI355X), found %d CUs; nothing launched\n", cus); grid = -1; return; }
        grid = 256;
    }
    if (grid < 0) return;
    (void)hipMemsetAsync(p.bar(), 0, ctl_bytes, stream);
    hipLaunchKernelGGL(mega, dim3(grid), dim3(512), LDS_TOTAL, stream, p, 0, NPHASE);
}
```
